# Optimizing an MI355X kernel written in HIP

```python
import jax, jax.numpy as jnp
from jax import lax
import numpy as np

D_MODEL = 1024
BATCH = 8
SEQ = 2048
DEPTH = 2
DEC_BATCH = 128
DEC_SEQ = 1
PAST_LEN = 16384
PAGE_SIZE = 128

CHUNK = 128
D_CM = D_MODEL
CM_GROUPS = 8
CM_GROUP_DIM = D_CM // CM_GROUPS
EXPAND = 2
D_INNER = EXPAND * D_MODEL
SSD_HEAD_DIM = 64
SSD_HEADS = D_INNER // SSD_HEAD_DIM
SSD_GROUPS = 4
SSD_STATE = 128
CONV_K = 4
CONV_DIM = D_INNER + 2 * SSD_GROUPS * SSD_STATE
D_FF = ((8 * D_MODEL + 3 * 256 - 1) // (3 * 256)) * 256
IN_COLS = 2 * D_CM + D_INNER + CONV_DIM + SSD_HEADS + 2 * D_MODEL
ALPHA = (2 * DEPTH) ** 0.25
BETA = (8 * DEPTH) ** -0.25
LN_EPS = 1e-5

kernel_name = "gated_chunkmlp_ssd_deepnorm_adaln_step"


def layer_norm(x, g, b):
    xf = x.astype(jnp.float32)
    mu = jnp.mean(xf, axis=-1, keepdims=True)
    var = jnp.mean(jnp.square(xf - mu), axis=-1, keepdims=True)
    y = (xf - mu) * lax.rsqrt(var + LN_EPS)
    return (y * g.astype(jnp.float32) + b.astype(jnp.float32)).astype(x.dtype)


def rms_norm(x, g):
    xf = x.astype(jnp.float32)
    y = xf * lax.rsqrt(jnp.mean(jnp.square(xf), axis=-1, keepdims=True) + LN_EPS)
    return (y * g.astype(jnp.float32)).astype(x.dtype)


def causal_dwconv(xp, w, b):
    L = xp.shape[1] - CONV_K + 1
    out = b
    for k in range(CONV_K):
        out = out + xp[:, k:k + L] * w[k]
    return out


def chunk_spatial_mix(v, w_s, b_s):
    Bsz, L, _ = v.shape
    ch = min(CHUNK, L)
    nc = L // ch
    mask = jnp.tril(jnp.ones((ch, ch), dtype=bool))
    w = jnp.where(mask[None], w_s[:, :ch, :ch], 0.0).astype(v.dtype)
    bias = b_s[:, :ch].astype(v.dtype)
    v4 = v.reshape(Bsz, nc, ch, CM_GROUPS, CM_GROUP_DIM)
    out = jnp.einsum('gij,bcjgd->bcigd', w, v4) + bias.T[None, None, :, :, None]
    return out.reshape(Bsz, L, D_CM)


def ssd_scan(x, dt, a, bm, cm, h0):
    Bsz, L, H, P = x.shape
    G, N = SSD_GROUPS, SSD_STATE
    E = H // G
    ch = min(CHUNK, L)
    nc = L // ch
    f32 = jnp.float32
    xdt = (x.astype(f32) * dt[..., None]).reshape(Bsz, nc, ch, G, E, P)
    bmf = bm.astype(f32).reshape(Bsz, nc, ch, G, N)
    cmf = cm.astype(f32).reshape(Bsz, nc, ch, G, N)
    acum = jnp.cumsum((dt * a).reshape(Bsz, nc, ch, G, E), axis=2)
    seg = acum[:, :, :, None] - acum[:, :, None, :]
    causal = jnp.tril(jnp.ones((ch, ch), dtype=bool))[None, None, :, :, None, None]
    lmat = jnp.exp(jnp.where(causal, seg, -jnp.inf))
    cb = jnp.einsum('bclgn,bcsgn->bclsg', cmf, bmf)
    y_diag = jnp.einsum('bclsg,bclsge,bcsgep->bclgep', cb, lmat, xdt)
    decay_to_end = jnp.exp(acum[:, :, -1:] - acum)
    chunk_states = jnp.einsum('bclgn,bclge,bclgep->bcgepn', bmf, decay_to_end, xdt)
    chunk_decay = jnp.exp(acum[:, :, -1])

    def step(h, inp):
        dec, st = inp
        return h * dec[..., None, None] + st, h

    h_init = h0.astype(f32).reshape(Bsz, G, E, P, N)
    h_last, h_prev = lax.scan(step, h_init,
                              (jnp.moveaxis(chunk_decay, 1, 0), jnp.moveaxis(chunk_states, 1, 0)))
    y_off = jnp.einsum('bclgn,bclge,cbgepn->bclgep', cmf, jnp.exp(acum), h_prev)
    y = (y_diag + y_off).reshape(Bsz, L, H, P).astype(x.dtype)
    return y, h_last.reshape(Bsz, H, P, N)


def block(x, c, conv_buf, h0, lp):
    Bsz, L, _ = x.shape
    mod = jax.nn.silu(c) @ lp['w_ada'] + lp['b_ada']
    sh1, sc1, g1, sh2, sc2, g2 = jnp.split(mod[:, None, :], 6, axis=-1)
    h = x * (1 + sc1) + sh1
    proj = h @ lp['w_in']
    cuts = np.cumsum([D_CM, D_CM, D_INNER, CONV_DIM, SSD_HEADS, D_MODEL]).tolist()
    u, v, z, xbc, dt_raw, gate_cm, gate_ssd = jnp.split(proj, cuts, axis=-1)

    u = jax.nn.gelu(u, approximate=False)
    v = layer_norm(jax.nn.gelu(v, approximate=False), lp['ln_v_g'], lp['ln_v_b'])
    out_cm = u * chunk_spatial_mix(v, lp['w_spatial'], lp['b_spatial'])

    xbc_full = jnp.concatenate([conv_buf.astype(xbc.dtype), xbc], axis=1)
    new_conv = xbc_full[:, xbc_full.shape[1] - (CONV_K - 1):]
    xbc_c = jax.nn.silu(causal_dwconv(xbc_full, lp['conv_w'], lp['conv_b']))
    xs, bm, cmat = jnp.split(xbc_c, [D_INNER, D_INNER + SSD_GROUPS * SSD_STATE], axis=-1)
    xs = xs.reshape(Bsz, L, SSD_HEADS, SSD_HEAD_DIM)
    bm = bm.reshape(Bsz, L, SSD_GROUPS, SSD_STATE)
    cmat = cmat.reshape(Bsz, L, SSD_GROUPS, SSD_STATE)
    dt = jax.nn.softplus((dt_raw + lp['dt_bias']).astype(jnp.float32))
    a = -jnp.exp(lp['a_log'].astype(jnp.float32))
    y, h_last = ssd_scan(xs, dt, a, bm, cmat, h0)
    y = y + lp['d_skip'][:, None] * xs
    y = rms_norm(y.reshape(Bsz, L, D_INNER) * jax.nn.silu(z), lp['ssd_norm_w'])

    merged = (jax.nn.sigmoid(gate_cm + lp['b_gate'][:D_MODEL]) * (out_cm @ lp['w_cm_br'])
              + jax.nn.sigmoid(gate_ssd + lp['b_gate'][D_MODEL:]) * (y @ lp['w_ssd_br']))
    x = layer_norm(ALPHA * x + g1 * (merged @ lp['w_o']), lp['ln1_g'], lp['ln1_b'])

    h2 = x * (1 + sc2) + sh2
    ffn = (jax.nn.silu(h2 @ lp['w_ffn_gate']) * (h2 @ lp['w_ffn_up'])) @ lp['w_ffn_down']
    x = layer_norm(ALPHA * x + g2 * ffn, lp['ln2_g'], lp['ln2_b'])
    return x, new_conv, h_last.astype(h0.dtype), v


def setup_inputs(seed: int = 0) -> dict:
    key = jax.random.key(seed)
    ks = iter(jax.random.split(key, 40))
    f32 = jnp.float32

    def nrm(shape, s):
        return jax.random.normal(next(ks), shape, f32) * s

    dt0 = jnp.exp(jax.random.uniform(next(ks), (DEPTH, SSD_HEADS), f32,
                                     np.log(1e-3).astype(np.float32), np.log(1e-1).astype(np.float32)))
    return {
        'x_prompt': nrm((BATCH, SEQ, D_MODEL), 1.0),
        'x_sample': nrm((DEC_BATCH, DEC_SEQ, D_MODEL), 1.0),
        'state_ssd': nrm((DEPTH, DEC_BATCH, SSD_HEADS, SSD_HEAD_DIM, SSD_STATE), 0.1),
        'state_conv': nrm((DEPTH, DEC_BATCH, CONV_K - 1, CONV_DIM), 1.0),
        'c_prompt': nrm((BATCH, D_MODEL), 1.0),
        'c_sample': nrm((DEC_BATCH, D_MODEL), 1.0),
        'w_ada': nrm((DEPTH, D_MODEL, 6 * D_MODEL), 0.5 * D_MODEL ** -0.5),
        'b_ada': nrm((DEPTH, 6 * D_MODEL), 0.02),
        'w_in': nrm((DEPTH, D_MODEL, IN_COLS), D_MODEL ** -0.5),
        'b_gate': nrm((DEPTH, 2 * D_MODEL), 0.02),
        'ln_v_g': 1.0 + nrm((DEPTH, D_CM), 0.02),
        'ln_v_b': nrm((DEPTH, D_CM), 0.02),
        'w_spatial': nrm((DEPTH, CM_GROUPS, CHUNK, CHUNK), 0.5 * CHUNK ** -0.5),
        'b_spatial': 1.0 + nrm((DEPTH, CM_GROUPS, CHUNK), 0.02),
        'conv_w': nrm((DEPTH, CONV_K, CONV_DIM), CONV_K ** -0.5),
        'conv_b': nrm((DEPTH, CONV_DIM), 0.02),
        'dt_bias': dt0 + jnp.log(-jnp.expm1(-dt0)),
        'a_log': jnp.log(jax.random.uniform(next(ks), (DEPTH, SSD_HEADS), f32, 1.0, 16.0)),
        'd_skip': 1.0 + nrm((DEPTH, SSD_HEADS), 0.02),
        'ssd_norm_w': 1.0 + nrm((DEPTH, D_INNER), 0.02),
        'w_cm_br': nrm((DEPTH, D_CM, D_MODEL), D_CM ** -0.5),
        'w_ssd_br': nrm((DEPTH, D_INNER, D_MODEL), D_INNER ** -0.5),
        'w_o': nrm((DEPTH, D_MODEL, D_MODEL), BETA * D_MODEL ** -0.5),
        'ln1_g': 1.0 + nrm((DEPTH, D_MODEL), 0.02),
        'ln1_b': nrm((DEPTH, D_MODEL), 0.02),
        'w_ffn_gate': nrm((DEPTH, D_MODEL, D_FF), D_MODEL ** -0.5),
        'w_ffn_up': nrm((DEPTH, D_MODEL, D_FF), D_MODEL ** -0.5),
        'w_ffn_down': nrm((DEPTH, D_FF, D_MODEL), BETA * D_FF ** -0.5),
        'ln2_g': 1.0 + nrm((DEPTH, D_MODEL), 0.02),
        'ln2_b': nrm((DEPTH, D_MODEL), 0.02),
    }


def reference(x_prompt, x_sample, state_ssd, state_conv, c_prompt, c_sample,
              w_ada, b_ada, w_in, b_gate, ln_v_g, ln_v_b, w_spatial, b_spatial,
              conv_w, conv_b, dt_bias, a_log, d_skip, ssd_norm_w, w_cm_br, w_ssd_br,
              w_o, ln1_g, ln1_b, w_ffn_gate, w_ffn_up, w_ffn_down, ln2_g, ln2_b):
    def layer_params(i):
        return {'w_ada': w_ada[i], 'b_ada': b_ada[i], 'w_in': w_in[i], 'b_gate': b_gate[i],
                'ln_v_g': ln_v_g[i], 'ln_v_b': ln_v_b[i], 'w_spatial': w_spatial[i],
                'b_spatial': b_spatial[i], 'conv_w': conv_w[i], 'conv_b': conv_b[i],
                'dt_bias': dt_bias[i], 'a_log': a_log[i], 'd_skip': d_skip[i],
                'ssd_norm_w': ssd_norm_w[i], 'w_cm_br': w_cm_br[i], 'w_ssd_br': w_ssd_br[i],
                'w_o': w_o[i], 'ln1_g': ln1_g[i], 'ln1_b': ln1_b[i], 'w_ffn_gate': w_ffn_gate[i],
                'w_ffn_up': w_ffn_up[i], 'w_ffn_down': w_ffn_down[i], 'ln2_g': ln2_g[i],
                'ln2_b': ln2_b[i]}

    xp = x_prompt
    conv0_p = jnp.zeros((BATCH, CONV_K - 1, CONV_DIM), x_prompt.dtype)
    h0_p = jnp.zeros((BATCH, SSD_HEADS, SSD_HEAD_DIM, SSD_STATE), state_ssd.dtype)
    conv_p, ssd_p = [], []
    xs = x_sample
    conv_s, ssd_s, v_s = [], [], []
    for i in range(DEPTH):
        lp = layer_params(i)
        xp, cp, hp, _ = block(xp, c_prompt, conv0_p, h0_p, lp)
        conv_p.append(cp)
        ssd_p.append(hp)
        xs, cs, hs, vs = block(xs, c_sample, state_conv[i], state_ssd[i], lp)
        conv_s.append(cs)
        ssd_s.append(hs)
        v_s.append(vs)
    return (xp, xs, jnp.stack(ssd_p), jnp.stack(conv_p), jnp.stack(ssd_s), jnp.stack(conv_s), jnp.stack(v_s))
```

```cpp
#include <hip/hip_runtime.h>
#include <hip/hip_cooperative_groups.h>
#include <cstdio>
namespace cg = cooperative_groups;

#ifndef REP_W
#define REP_W 1
#define REP_G1 1
#define REP_C 1
#define REP_S1 1
#define REP_S3 1
#define REP_G2 1
#define REP_G4 1
#endif
#ifndef MK_ONE_LAUNCH
#define MK_ONE_LAUNCH 1
#endif

typedef unsigned short bf16_t;
typedef short bf16x8 __attribute__((ext_vector_type(8)));
typedef float f32x16 __attribute__((ext_vector_type(16)));
typedef float f32x4 __attribute__((ext_vector_type(4)));
typedef unsigned u32x4 __attribute__((ext_vector_type(4)));

constexpr int DM = 1024, NB = 8, SEQ = 2048, MPR = NB * SEQ, NS = 128, MT = MPR + NS;
constexpr int DI = 2048, CD = 3072, NH = 32, DFF = 2816, NIN = 9472, NCK = 16;
constexpr int MODLD = 12288, NMOD = 136;
constexpr float ALPHA = 1.41421356237309515f;
constexpr float EPS = 1e-5f;
constexpr int THREADS = 256;
constexpr int BLOCK = 512;
constexpr int GS = 72;
constexpr int GT = 128 * GS;
constexpr int TS = 136;
constexpr int HALF_LDS = 4 * GT * 2;
constexpr int LDS_BYTES = 2 * HALF_LDS;

constexpr size_t O0 = 0, O1 = O0 + (size_t)MPR * DM, O2 = O1 + (size_t)NS * DM, O3 = O2 + (size_t)2 * NB * NH * 64 * 128,
                 O4 = O3 + (size_t)2 * NB * 3 * CD, O5 = O4 + (size_t)2 * NS * NH * 64 * 128, O6 = O5 + (size_t)2 * NS * 3 * CD;

struct P {
    const float *x_prompt, *x_sample, *state_ssd, *state_conv, *c_prompt, *c_sample, *w_ada, *b_ada, *w_in, *b_gate, *ln_v_g, *ln_v_b, *w_spatial,
        *b_spatial, *conv_w, *conv_b, *dt_bias, *a_log, *d_skip, *ssd_norm_w, *w_cm_br, *w_ssd_br, *w_o, *ln1_g, *ln1_b, *w_ffn_gate, *w_ffn_up,
        *w_ffn_down, *ln2_g, *ln2_b;
    float* out;
    bf16_t *Wt_in, *Wt_cm, *Wt_ssd, *Wt_o, *Wt_gu, *Wt_d, *Wt_ada, *SC;
    float *mod, *XB, *DT, *VST, *ST, *CDEC, *SSQ;
    bf16_t *H, *UG, *VG, *SZ, *XBC, *GCM, *GSSD, *XC, *OCM, *YG, *MRG, *GU, *ST16;
    unsigned* bar;
    int ph_lo, ph_hi, coop, pad;
};

__device__ __forceinline__ float bf2f(unsigned h) { return __uint_as_float(h << 16); }
__device__ __forceinline__ unsigned pk2(float lo, float hi) { unsigned r; asm("v_cvt_pk_bf16_f32 %0, %1, %2" : "=v"(r) : "v"(lo), "v"(hi)); return r; }
__device__ __forceinline__ bf16_t f2bf(float f) { return (bf16_t)(pk2(f, 0.f) & 0xffffu); }
__device__ __forceinline__ float lo16(unsigned u) { return __uint_as_float(u << 16); }
__device__ __forceinline__ float hi16(unsigned u) { return __uint_as_float(u & 0xffff0000u); }
__device__ __forceinline__ float sigmoid_f(float x) { return __builtin_amdgcn_rcpf(1.f + __builtin_amdgcn_exp2f(x * -1.44269504089f)); }
__device__ __forceinline__ float silu_f(float x) { return x * sigmoid_f(x); }
__device__ __forceinline__ float gelu_f(float v) {
    const float av = fabsf(v), t = __builtin_amdgcn_rcpf(av * 0.2316418882f + 1.0f);
    float q = t * 0.5307027145f + (-0.7265760135f); q = q * t + 0.7107068705f; q = q * t + (-0.142248368f); q = q * t + 0.127414796f; q = q * t;
    const float e = __builtin_amdgcn_exp2f((v * v) * (-0.72134752044f));
    const float m = v * (q * e);
    return v < 0.f ? m : v - m;
}
typedef float f32x2 __attribute__((ext_vector_type(2)));
__device__ __forceinline__ f32x2 gelu_pk2(float a, float b) { return (f32x2){gelu_f(a), gelu_f(b)}; }
__device__ __forceinline__ float softplus_f(float x) { return fmaxf(x, 0.f) + __logf(1.f + __expf(-fabsf(x))); }
__device__ __forceinline__ int modrow(int m) { return m < MPR ? (m >> 11) : (NB + m - MPR); }
__device__ __forceinline__ float wave_sum(float v) {
#pragma unroll
    for (int o = 32; o > 0; o >>= 1) v += __shfl_xor(v, o);
    return v;
}

__device__ __forceinline__ int tidx() { int t = threadIdx.x & 255; asm volatile("" : "+v"(t)); return t; }
__device__ __forceinline__ int vhalf() { return __builtin_amdgcn_readfirstlane((int)(threadIdx.x >> 8)); }
__device__ __forceinline__ int bidx() { int b = 2 * blockIdx.x + vhalf(); asm volatile("" : "+s"(b)); return b; }
__device__ __forceinline__ int vgrid() { return 2 * gridDim.x; }

__device__ __forceinline__ void gemm_mainloop(f32x16 (&acc)[2][2], const bf16_t* __restrict__ A, int lda, const bf16_t* __restrict__ Bt, int ldb,
                                              int K, int m0, int n0, bf16_t* smem) {
    const int tid = tidx(), lane = tid & 63, wave = tid >> 6, wm = wave >> 1, wn = wave & 1;
    const int lr = tid >> 3, lc = (tid & 7) * 8;
    const bf16_t* Ap = A + (size_t)(m0 + lr) * lda + lc;
    const bf16_t* Bp = Bt + (size_t)(n0 + lr) * ldb + lc;
    u32x4 ra0, ra1, ra2, ra3, rb0, rb1, rb2, rb3, sa0, sa1, sa2, sa3, sb0, sb1, sb2, sb3;
#define G_LOAD(A0, A1, A2, A3, B0, B1, B2, B3, koff)                                           \
    A0 = *(const u32x4*)(Ap + (koff)); A1 = *(const u32x4*)(Ap + (size_t)32 * lda + (koff));   \
    A2 = *(const u32x4*)(Ap + (size_t)64 * lda + (koff)); A3 = *(const u32x4*)(Ap + (size_t)96 * lda + (koff)); \
    B0 = *(const u32x4*)(Bp + (koff)); B1 = *(const u32x4*)(Bp + (size_t)32 * ldb + (koff));   \
    B2 = *(const u32x4*)(Bp + (size_t)64 * ldb + (koff)); B3 = *(const u32x4*)(Bp + (size_t)96 * ldb + (koff));
#define G_STORE(D, A0, A1, A2, A3, B0, B1, B2, B3)                                    \
    *(u32x4*)((D) + lr * GS + lc) = A0; *(u32x4*)((D) + (lr + 32) * GS + lc) = A1;    \
    *(u32x4*)((D) + (lr + 64) * GS + lc) = A2; *(u32x4*)((D) + (lr + 96) * GS + lc) = A3; \
    *(u32x4*)((D) + GT + lr * GS + lc) = B0; *(u32x4*)((D) + GT + (lr + 32) * GS + lc) = B1; \
    *(u32x4*)((D) + GT + (lr + 64) * GS + lc) = B2; *(u32x4*)((D) + GT + (lr + 96) * GS + lc) = B3;
#define G_COMPUTE(S)                                                                                                       \
    _Pragma("unroll") for (int ks = 0; ks < 4; ++ks) {                                                                     \
        const bf16x8 af0 = *(const bf16x8*)((S) + aoff + ks * 16), af1 = *(const bf16x8*)((S) + aoff + 32 * GS + ks * 16); \
        const bf16x8 bf0 = *(const bf16x8*)((S) + boff + ks * 16), bf1 = *(const bf16x8*)((S) + boff + 32 * GS + ks * 16); \
        acc[0][0] = __builtin_amdgcn_mfma_f32_32x32x16_bf16(bf0, af0, acc[0][0], 0, 0, 0);                                 \
        acc[0][1] = __builtin_amdgcn_mfma_f32_32x32x16_bf16(bf1, af0, acc[0][1], 0, 0, 0);                                 \
        acc[1][0] = __builtin_amdgcn_mfma_f32_32x32x16_bf16(bf0, af1, acc[1][0], 0, 0, 0);                                 \
        acc[1][1] = __builtin_amdgcn_mfma_f32_32x32x16_bf16(bf1, af1, acc[1][1], 0, 0, 0);                                 \
    }
    const int nk = K >> 6;
    const int aoff = (wm * 64 + (lane & 31)) * GS + (lane >> 5) * 8;
    const int boff = GT + (wn * 64 + (lane & 31)) * GS + (lane >> 5) * 8;
    G_LOAD(ra0, ra1, ra2, ra3, rb0, rb1, rb2, rb3, 0)
    { const int k1 = (nk > 1) ? 64 : 0; G_LOAD(sa0, sa1, sa2, sa3, sb0, sb1, sb2, sb3, k1) }
    __syncthreads();
    G_STORE(smem, ra0, ra1, ra2, ra3, rb0, rb1, rb2, rb3)
    __syncthreads();
    bf16_t* S0 = smem; bf16_t* S1 = smem + 2 * GT;
    for (int kt = 0; kt < nk; kt += 2) {
        { const int kn = (kt + 2 < nk ? kt + 2 : nk - 1) * 64; G_LOAD(ra0, ra1, ra2, ra3, rb0, rb1, rb2, rb3, kn) }
        G_COMPUTE(S0)
        if (kt + 1 < nk) { G_STORE(S1, sa0, sa1, sa2, sa3, sb0, sb1, sb2, sb3) }
        __syncthreads();
        if (kt + 1 >= nk) break;
        { const int kn = (kt + 3 < nk ? kt + 3 : nk - 1) * 64; G_LOAD(sa0, sa1, sa2, sa3, sb0, sb1, sb2, sb3, kn) }
        G_COMPUTE(S1)
        if (kt + 2 < nk) { G_STORE(S0, ra0, ra1, ra2, ra3, rb0, rb1, rb2, rb3) }
        __syncthreads();
    }
#undef G_LOAD
#undef G_STORE
#undef G_COMPUTE
}

#define ZERO_ACC(acc)                                      \
    _Pragma("unroll") for (int _i = 0; _i < 2; ++_i)       \
        _Pragma("unroll") for (int _j = 0; _j < 2; ++_j)   \
            _Pragma("unroll") for (int _r = 0; _r < 16; ++_r) acc[_i][_j][_r] = 0.f;

#define EPI_BEGIN(acc, m0, n0)                                                                                     \
    {                                                                                                              \
        const int _lane = tidx() & 63, _wave = tidx() >> 6;                                              \
        _Pragma("unroll") for (int _mi = 0; _mi < 2; ++_mi) {                                                      \
            const int row = (m0) + (_wave >> 1) * 64 + _mi * 32 + (_lane & 31);                                    \
            _Pragma("unroll") for (int _ni = 0; _ni < 2; ++_ni) _Pragma("unroll") for (int _q = 0; _q < 4; ++_q) { \
                const int col = (n0) + (_wave & 1) * 64 + _ni * 32 + _q * 8 + (_lane >> 5) * 4;                    \
                float v0 = acc[_mi][_ni][4 * _q], v1 = acc[_mi][_ni][4 * _q + 1], v2 = acc[_mi][_ni][4 * _q + 2], v3 = acc[_mi][_ni][4 * _q + 3];
#define EPI_END \
    }           \
    }           \
    }

__device__ __forceinline__ void st_bf4(bf16_t* p, float a, float b, float c, float d) { *(uint2*)p = make_uint2(pk2(a, b), pk2(c, d)); }

__device__ void cvt_tile(const float* __restrict__ src, const float* __restrict__ src2, const float* __restrict__ kscale, bf16_t* __restrict__ dst, int K,
                         int Nsrc, int mode, int tk, int tn, float* tile) {
    const int tid = tidx(), nn = (tid & 15) * 4, kb = tid >> 4;
    const int np = tn * 64 + nn;
    const float* s = src; int n = np; bool valid = true;
    if (mode == 1) { if (np < 7168) n = np; else if (np < 9216) n = np + 32; else if (np < 9248) n = np - 2048; else { valid = false; n = 0; } }
    else if (mode == 2) { const int q = np >> 5, r = np & 31; n = q * 16 + (r & 15); s = (r < 16) ? src : src2; }
    __syncthreads();
#pragma unroll
    for (int i = 0; i < 4; ++i) {
        const int k = tk * 64 + kb + 16 * i;
        float4 v = make_float4(0.f, 0.f, 0.f, 0.f);
        if (valid) { const f32x4 t = __builtin_nontemporal_load((const f32x4*)(s + (size_t)k * Nsrc + n)); v = make_float4(t[0], t[1], t[2], t[3]); }
        if (kscale) { const float sc = kscale[k]; v.x *= sc; v.y *= sc; v.z *= sc; v.w *= sc; }
        float* t = tile + (kb + 16 * i) * 65 + nn;
        t[0] = v.x; t[1] = v.y; t[2] = v.z; t[3] = v.w;
    }
    __syncthreads();
    const int orow = tid >> 2, kc = (tid & 3) * 16;
    unsigned w[8];
#pragma unroll
    for (int j = 0; j < 8; ++j) w[j] = pk2(tile[(kc + 2 * j) * 65 + orow], tile[(kc + 2 * j + 1) * 65 + orow]);
    bf16_t* d = dst + (size_t)(tn * 64 + orow) * K + tk * 64 + kc;
    *(uint4*)d = make_uint4(w[0], w[1], w[2], w[3]);
    *(uint4*)(d + 8) = make_uint4(w[4], w[5], w[6], w[7]);
}

constexpr int CT_IN = 16 * 148, CT_CM = 256, CT_SSD = 32 * 16, CT_O = 256, CT_GU = 16 * 88, CT_D = 44 * 16, CT_ADA = 16 * 96;
constexpr int CT_LAYER = CT_IN + CT_CM + CT_SSD + CT_O + CT_GU + CT_D + CT_ADA;
constexpr int CT_ALL = 2 * CT_LAYER, SC_TASKS = 64;

__device__ void phase_w(const P& p, float* smemf) {
    for (int t = bidx(); t < CT_ALL + SC_TASKS; t += vgrid()) {
        if (t >= CT_ALL) {
            const int base = (t - CT_ALL) * 4096;
#pragma unroll
            for (int i = 0; i < 16; ++i) {
                const int e = base + i * 256 + tidx(), r = e >> 10, k = e & 1023;
                float v = 0.f;
                if (r < NB) v = silu_f(p.c_prompt[r * DM + k]); else if (r < NMOD) v = silu_f(p.c_sample[(r - NB) * DM + k]);
                p.SC[e] = f2bf(v);
            }
            continue;
        }
        const int L = t / CT_LAYER; int r = t % CT_LAYER;
        if (r < CT_IN) { cvt_tile(p.w_in + (size_t)L * DM * 9248, nullptr, nullptr, p.Wt_in + (size_t)L * NIN * DM, DM, 9248, 1, r % 16, r / 16, smemf); continue; }
        r -= CT_IN;
        if (r < CT_CM) { cvt_tile(p.w_cm_br + (size_t)L * DM * DM, nullptr, nullptr, p.Wt_cm + (size_t)L * DM * DM, DM, DM, 0, r % 16, r / 16, smemf); continue; }
        r -= CT_CM;
        if (r < CT_SSD) { cvt_tile(p.w_ssd_br + (size_t)L * DI * DM, nullptr, p.ssd_norm_w + L * DI, p.Wt_ssd + (size_t)L * DM * DI, DI, DM, 0, r % 32, r / 32, smemf); continue; }
        r -= CT_SSD;
        if (r < CT_O) { cvt_tile(p.w_o + (size_t)L * DM * DM, nullptr, nullptr, p.Wt_o + (size_t)L * DM * DM, DM, DM, 0, r % 16, r / 16, smemf); continue; }
        r -= CT_O;
        if (r < CT_GU) { cvt_tile(p.w_ffn_gate + (size_t)L * DM * DFF, p.w_ffn_up + (size_t)L * DM * DFF, nullptr, p.Wt_gu + (size_t)L * 2 * DFF * DM, DM, DFF, 2, r % 16, r / 16, smemf); continue; }
        r -= CT_GU;
        if (r < CT_D) { cvt_tile(p.w_ffn_down + (size_t)L * DFF * DM, nullptr, nullptr, p.Wt_d + (size_t)L * DM * DFF, DFF, DM, 0, r % 44, r / 44, smemf); continue; }
        r -= CT_D;
        cvt_tile(p.w_ada + (size_t)L * DM * 6144, nullptr, nullptr, p.Wt_ada + (size_t)L * 6144 * DM, DM, 6144, 0, r % 16, r / 16, smemf);
    }
}

__device__ void phase_ada(const P& p, bf16_t* smem) {
    for (int t = bidx(); t < 2 * 96; t += vgrid()) {
        const int m0 = (t / 96) * 128, n0 = (t % 96) * 128;
        f32x16 acc[2][2]; ZERO_ACC(acc);
        gemm_mainloop(acc, p.SC, DM, p.Wt_ada, DM, DM, m0, n0, smem);
        EPI_BEGIN(acc, m0, n0)
            if (row < NMOD) {
                const float4 b = *(const float4*)(p.b_ada + col);
                *(float4*)(p.mod + (size_t)row * MODLD + col) = make_float4(v0 + b.x, v1 + b.y, v2 + b.z, v3 + b.w);
            }
        EPI_END
    }
}

__device__ void phase_e0(const P& p) {
    const int nth = vgrid() * THREADS;
    for (int i0 = bidx() * THREADS + tidx(); i0 < MT * 256; i0 += 4 * nth) {
        float4 x[4], sh[4], sc[4];
#pragma unroll
        for (int u = 0; u < 4; ++u) {
            const int i = i0 + u * nth;
            if (i < MT * 256) {
                const int m = i >> 8, k4 = (i & 255) * 4;
                const float* xr = m < MPR ? p.x_prompt + (size_t)m * DM : p.x_sample + (size_t)(m - MPR) * DM;
                const float* md = p.mod + (size_t)modrow(m) * MODLD;
                x[u] = *(const float4*)(xr + k4); sh[u] = *(const float4*)(md + k4); sc[u] = *(const float4*)(md + 1024 + k4);
            }
        }
#pragma unroll
        for (int u = 0; u < 4; ++u) {
            const int i = i0 + u * nth;
            if (i < MT * 256) {
                const int m = i >> 8, k4 = (i & 255) * 4;
                st_bf4(p.H + (size_t)m * DM + k4, x[u].x * (1.f + sc[u].x) + sh[u].x, x[u].y * (1.f + sc[u].y) + sh[u].y, x[u].z * (1.f + sc[u].z) + sh[u].z, x[u].w * (1.f + sc[u].w) + sh[u].w);
            }
        }
    }
}

#define PG8_LAS __attribute__((address_space(3)))
typedef float f32x4 __attribute__((ext_vector_type(4)));
namespace pg8 {
constexpr int BM = 256, BK = 64, HALF = 128, HTB = HALF * BK * 2, NXCD = 8, WGM = 8;
__device__ __forceinline__ int lds_byte(int r, int c) { const int st = (r >> 4) * 2 + (c >> 5), rr = r & 15, cc = c & 31, ob = rr * 64 + cc * 2; return st * 1024 + (ob ^ (((ob >> 9) & 1) << 5)); }
__device__ __forceinline__ int perm32(int rho) { const int n = rho >> 4, i = rho & 15; return 8 * (i >> 2) + 4 * n + (i & 3); }
__device__ __forceinline__ void stage_rc(int b, int& R, int& C) { const int st = b / 1024, sb = b % 1024, swz = sb ^ (((sb >> 9) & 1) << 5); R = (st >> 1) * 16 + swz / 64; C = (st & 1) * 32 + (swz % 64) / 2; }
struct Unit { int pm, pn; };
struct Gemm { const bf16_t* A; const bf16_t* Bt; int M, N, K; };
struct StaticOrder {
    int nM, nN, nwg, G, c;
    __device__ void init(int M, int N, int G_, int c_) { nM = M / BM; nN = N / BM; nwg = nM * nN; G = G_; c = c_; }
    __device__ bool next(int i, Unit& u) const {
        const long L = (long)i * G + c; if (L >= nwg) return false;
        int wgid = (int)L; { const int q = nwg / NXCD, r = nwg % NXCD, xcd = wgid % NXCD, off = wgid / NXCD; wgid = (xcd < r ? xcd * (q + 1) : r * (q + 1) + (xcd - r) * q) + off; }
        const int nig = WGM * nN, gid = wgid / nig, fm = gid * WGM, gsz = (nM - fm) < WGM ? (nM - fm) : WGM;
        u.pm = fm + ((wgid % nig) % gsz); u.pn = (wgid % nig) / gsz; return true;
    }
};
template <class Epi>
__device__ __forceinline__ void gemm_phase(PG8_LAS unsigned char* lds, const Gemm g, const StaticOrder& S, const Epi& E) {
    int tid = threadIdx.x; asm volatile("" : "+v"(tid));
    const int wid = __builtin_amdgcn_readfirstlane(tid >> 6), lane = tid & 63, wr = wid >> 2, wc = wid & 3, fr = lane & 15, fq = lane >> 4;
    const int K = g.K, nt = K / BK;
    unsigned voffA[2], voffB[2];
#pragma unroll
    for (int i = 0; i < 2; ++i) { int R, C; stage_rc(tid * 16 + i * 8192, R, C); const int Rb = Epi::PERM ? ((R & ~31) + perm32(R & 31)) : R;
        voffA[i] = (unsigned)(R * K + C) * 2u; voffB[i] = (unsigned)(Rb * K + C) * 2u; }
    const size_t kstep = (size_t)(BK * 2);
    const size_t hstep = (size_t)HALF * K * 2;
    const size_t tstep = 2 * hstep;
    const unsigned ldsw = (unsigned)wid * 1024u;
    const int aoff = lds_byte(wr * 64 + fr, fq * 8), boff = lds_byte(wc * 32 + fr, fq * 8);
#define PG8_SA(b, h) (((b) * 2 + (h)) * HTB)
#define PG8_SB(b, h) ((4 + (b) * 2 + (h)) * HTB)
#define PG8_STAGE2(bufoff, gbase, voff) do { _Pragma("unroll") for (int _i = 0; _i < 2; ++_i) \
        __builtin_amdgcn_global_load_lds((const unsigned*)((const char*)(gbase) + (voff)[_i]), (PG8_LAS unsigned*)(lds + (bufoff) + ldsw + _i * 8192), 16, 0, 0); } while (0)
#define PG8_LDA(dst, b, h) do { _Pragma("unroll") for (int m = 0; m < 4; ++m) _Pragma("unroll") for (int k = 0; k < 2; ++k) dst[m][k] = *(const PG8_LAS bf16x8*)(lds + PG8_SA(b, h) + aoff + m * 2048 + k * 1024); } while (0)
#define PG8_LDB(dst, b, h) do { _Pragma("unroll") for (int n = 0; n < 2; ++n) _Pragma("unroll") for (int k = 0; k < 2; ++k) dst[n][k] = *(const PG8_LAS bf16x8*)(lds + PG8_SB(b, h) + boff + n * 2048 + k * 1024); } while (0)
#define PG8_MMA(ai, bj, At, Bt) do { __builtin_amdgcn_s_setprio(1); _Pragma("unroll") for (int m = 0; m < 4; ++m) _Pragma("unroll") for (int n = 0; n < 2; ++n) _Pragma("unroll") for (int k = 0; k < 2; ++k) \
        acc[ai][bj][m][n] = __builtin_amdgcn_mfma_f32_16x16x32_bf16(Bt[n][k], At[m][k], acc[ai][bj][m][n], 0, 0, 0); __builtin_amdgcn_s_setprio(0); } while (0)
#define PG8_WAIT_V(n) asm volatile("s_waitcnt vmcnt(" #n ")" ::: "memory")
#define PG8_WAIT_L(n) asm volatile("s_waitcnt lgkmcnt(" #n ")" ::: "memory")
#define PG8_BAR __builtin_amdgcn_s_barrier()
#define PG8_SCHED __builtin_amdgcn_sched_barrier(0)
    Unit cur, nxt; int ui = 0;
    if (!S.next(0, cur)) return;
    f32x4 acc[2][2][4][2];
#pragma unroll
    for (int a = 0; a < 2; ++a)
#pragma unroll
        for (int b = 0; b < 2; ++b)
#pragma unroll
            for (int m = 0; m < 4; ++m)
#pragma unroll
                for (int n = 0; n < 2; ++n) acc[a][b][m][n] = (f32x4){0.f, 0.f, 0.f, 0.f};
    bf16x8 At[4][2], B0[2][2], B1[2][2];
    const char* cA = (const char*)g.A + (size_t)cur.pm * tstep; const char* cB = (const char*)g.Bt + (size_t)cur.pn * tstep;
    PG8_STAGE2(PG8_SB(0, 0), cB, voffB); PG8_STAGE2(PG8_SA(0, 0), cA, voffA); PG8_STAGE2(PG8_SB(0, 1), cB + hstep, voffB); PG8_STAGE2(PG8_SA(0, 1), cA + hstep, voffA);
    if (wr == 1) PG8_BAR;
    PG8_WAIT_V(4); PG8_BAR;
    PG8_STAGE2(PG8_SB(1, 0), cB + kstep, voffB); PG8_STAGE2(PG8_SA(1, 0), cA + kstep, voffA); PG8_STAGE2(PG8_SB(1, 1), cB + hstep + kstep, voffB);
    PG8_WAIT_V(6); PG8_BAR;
    for (;;) {
        const bool has_next = S.next(ui + 1, nxt);
        const char* nA = has_next ? (const char*)g.A + (size_t)nxt.pm * tstep : cA; const char* nB = has_next ? (const char*)g.Bt + (size_t)nxt.pn * tstep : cB;
        for (int t = 0; t < nt; t += 2) {
            const bool last = (t == nt - 2);
            const char* a1 = cA + (size_t)(t + 1) * kstep;
            const char* a2 = last ? nA : cA + (size_t)(t + 2) * kstep; const char* b2 = last ? nB : cB + (size_t)(t + 2) * kstep;
            const char* a3 = a2 + kstep; const char* b3 = b2 + kstep;
            PG8_LDB(B0, 0, 0); PG8_SCHED; PG8_LDA(At, 0, 0); PG8_STAGE2(PG8_SA(1, 1), a1 + hstep, voffA);
            PG8_WAIT_L(8); PG8_BAR; PG8_WAIT_L(0); PG8_MMA(0, 0, At, B0); PG8_BAR; PG8_SCHED;
            PG8_LDB(B1, 0, 1); PG8_STAGE2(PG8_SB(0, 0), b2, voffB);
            PG8_BAR; PG8_WAIT_L(0); PG8_MMA(0, 1, At, B1); PG8_BAR;
            PG8_LDA(At, 0, 1); PG8_STAGE2(PG8_SA(0, 0), a2, voffA);
            PG8_BAR; PG8_WAIT_L(0); PG8_MMA(1, 0, At, B0); PG8_BAR; PG8_SCHED;
            PG8_STAGE2(PG8_SB(0, 1), b2 + hstep, voffB);
            PG8_WAIT_V(6); PG8_BAR; PG8_MMA(1, 1, At, B1); PG8_BAR;
            PG8_LDB(B0, 1, 0); PG8_SCHED; PG8_LDA(At, 1, 0); PG8_STAGE2(PG8_SA(0, 1), a2 + hstep, voffA);
            PG8_WAIT_L(8); PG8_BAR; PG8_WAIT_L(0); PG8_MMA(0, 0, At, B0); PG8_BAR; PG8_SCHED;
            PG8_LDB(B1, 1, 1); PG8_STAGE2(PG8_SB(1, 0), b3, voffB);
            PG8_BAR; PG8_WAIT_L(0); PG8_MMA(0, 1, At, B1); PG8_BAR;
            PG8_LDA(At, 1, 1); PG8_STAGE2(PG8_SA(1, 0), a3, voffA);
            PG8_BAR; PG8_WAIT_L(0); PG8_MMA(1, 0, At, B0); PG8_BAR; PG8_SCHED;
            PG8_STAGE2(PG8_SB(1, 1), b3 + hstep, voffB);
            PG8_WAIT_V(6); PG8_BAR; PG8_MMA(1, 1, At, B1); PG8_BAR;
        }
        E(acc, cur, wr, wc, fr, fq);
        if (!has_next) break;
#pragma unroll
        for (int a = 0; a < 2; ++a)
#pragma unroll
            for (int b = 0; b < 2; ++b)
#pragma unroll
                for (int m = 0; m < 4; ++m)
#pragma unroll
                    for (int n = 0; n < 2; ++n) acc[a][b][m][n] = (f32x4){0.f, 0.f, 0.f, 0.f};
        cur = nxt; cA = nA; cB = nB; ++ui;
    }
    PG8_WAIT_V(0);
    if (wr == 0) PG8_BAR;
    PG8_BAR;
#undef PG8_SA
#undef PG8_SB
#undef PG8_STAGE2
#undef PG8_LDA
#undef PG8_LDB
#undef PG8_MMA
#undef PG8_WAIT_V
#undef PG8_WAIT_L
#undef PG8_BAR
#undef PG8_SCHED
}
}

typedef const f32x4 (&bigacc_t)[2][2][4][2];
#define BIG_LOOP                                                                                              \
    _Pragma("unroll") for (int ai = 0; ai < 2; ++ai) _Pragma("unroll") for (int m = 0; m < 4; ++m) {           \
        const int row = u.pm * 256 + ai * 128 + wr * 64 + m * 16 + fr;                                         \
        _Pragma("unroll") for (int bj = 0; bj < 2; ++bj) _Pragma("unroll") for (int n = 0; n < 2; ++n) {       \
            const int col = u.pn * 256 + bj * 128 + wc * 32 + n * 16 + 4 * fq;                                 \
            const float v0 = acc[ai][bj][m][n][0], v1 = acc[ai][bj][m][n][1], v2 = acc[ai][bj][m][n][2], v3 = acc[ai][bj][m][n][3];
#define BIG_END \
    }           \
    }

template <int R> __device__ __forceinline__ void epi_g1(const P& p, int L, int row, int col, float v0, float v1, float v2, float v3) {
    if (R == 0) st_bf4(p.UG + (size_t)row * DM + col, gelu_f(v0), gelu_f(v1), gelu_f(v2), gelu_f(v3));
    else if (R == 1) st_bf4(p.VG + (size_t)row * DM + (col - 1024), gelu_f(v0), gelu_f(v1), gelu_f(v2), gelu_f(v3));
    else if (R == 2) st_bf4(p.SZ + (size_t)row * DI + (col - 2048), silu_f(v0), silu_f(v1), silu_f(v2), silu_f(v3));
    else if (R == 3) st_bf4(p.XBC + (size_t)row * CD + (col - 4096), v0, v1, v2, v3);
    else if (R == 4) {
        const float4 b = *(const float4*)(p.b_gate + L * 2048 + (col - 7168));
        st_bf4(p.GCM + (size_t)row * DM + (col - 7168), sigmoid_f(v0 + b.x), sigmoid_f(v1 + b.y), sigmoid_f(v2 + b.z), sigmoid_f(v3 + b.w));
    } else if (R == 5) {
        const float4 b = *(const float4*)(p.b_gate + L * 2048 + 1024 + (col - 8192));
        st_bf4(p.GSSD + (size_t)row * DM + (col - 8192), sigmoid_f(v0 + b.x), sigmoid_f(v1 + b.y), sigmoid_f(v2 + b.z), sigmoid_f(v3 + b.w));
    } else {
        if (col < 9216 + 32) {
            const float4 b = *(const float4*)(p.dt_bias + L * NH + (col - 9216));
            *(float4*)(p.DT + (size_t)row * NH + (col - 9216)) = make_float4(softplus_f(v0 + b.x), softplus_f(v1 + b.y), softplus_f(v2 + b.z), softplus_f(v3 + b.w));
        }
    }
}
__device__ __forceinline__ void epi_res(const P& p, int L, int row, int col, float v0, float v1, float v2, float v3, const float* xr, int goff) {
    const float4 x = *(const float4*)(xr + col);
    const float4 g = *(const float4*)(p.mod + (size_t)modrow(row) * MODLD + L * 6144 + goff + col);
    *(float4*)(p.XB + (size_t)row * DM + col) = make_float4(ALPHA * x.x + g.x * v0, ALPHA * x.y + g.y * v1, ALPHA * x.z + g.z * v2, ALPHA * x.w + g.w * v3);
}
struct EpiBase { static constexpr bool PERM = false, AFTER_DRAIN = false; const P* pp; int L; };
struct EpiBaseP { static constexpr bool PERM = true, AFTER_DRAIN = false; const P* pp; int L; };
#define BIGP_LOOP                                                                                   \
    _Pragma("unroll") for (int ai = 0; ai < 2; ++ai) _Pragma("unroll") for (int m = 0; m < 4; ++m) { \
        const int row = u.pm * 256 + ai * 128 + wr * 64 + m * 16 + fr;                               \
        _Pragma("unroll") for (int bj = 0; bj < 2; ++bj) {                                           \
            const int col = u.pn * 256 + bj * 128 + wc * 32 + 8 * fq;                                \
            const f32x4 va = acc[ai][bj][m][0], vb = acc[ai][bj][m][1];
#define BIGP_END \
    }            \
    }
__device__ __forceinline__ void st_bf8(bf16_t* p, float a, float b, float c, float d, float e, float f, float g, float h) { *(u32x4*)p = (u32x4){pk2(a, b), pk2(c, d), pk2(e, f), pk2(g, h)}; }
template <int R> __device__ __forceinline__ void epi_g1p(const P& p, int L, int row, int col, const f32x4 va, const f32x4 vb) {
    if (R == 0) { const f32x2 a = gelu_pk2(va[0], va[1]), b = gelu_pk2(va[2], va[3]), c = gelu_pk2(vb[0], vb[1]), d = gelu_pk2(vb[2], vb[3]); st_bf8(p.UG + (size_t)row * DM + col, a.x, a.y, b.x, b.y, c.x, c.y, d.x, d.y); }
    else if (R == 1) { const f32x2 a = gelu_pk2(va[0], va[1]), b = gelu_pk2(va[2], va[3]), c = gelu_pk2(vb[0], vb[1]), d = gelu_pk2(vb[2], vb[3]); st_bf8(p.VG + (size_t)row * DM + (col - 1024), a.x, a.y, b.x, b.y, c.x, c.y, d.x, d.y); }
    else if (R == 2) st_bf8(p.SZ + (size_t)row * DI + (col - 2048), silu_f(va[0]), silu_f(va[1]), silu_f(va[2]), silu_f(va[3]), silu_f(vb[0]), silu_f(vb[1]), silu_f(vb[2]), silu_f(vb[3]));
    else if (R == 3) st_bf8(p.XBC + (size_t)row * CD + (col - 4096), va[0], va[1], va[2], va[3], vb[0], vb[1], vb[2], vb[3]);
    else if (R == 4 || R == 5) {
        const int gc = col - (R == 4 ? 7168 : 8192);
        const float* bg = p.b_gate + L * 2048 + (R == 4 ? 0 : 1024) + gc;
        const float4 b0 = *(const float4*)bg, b1 = *(const float4*)(bg + 4);
        st_bf8((R == 4 ? p.GCM : p.GSSD) + (size_t)row * DM + gc, sigmoid_f(va[0] + b0.x), sigmoid_f(va[1] + b0.y), sigmoid_f(va[2] + b0.z), sigmoid_f(va[3] + b0.w),
               sigmoid_f(vb[0] + b1.x), sigmoid_f(vb[1] + b1.y), sigmoid_f(vb[2] + b1.z), sigmoid_f(vb[3] + b1.w));
    } else {
        if (col < 9216 + 32) {
            const float* db = p.dt_bias + L * NH + (col - 9216);
            const float4 b0 = *(const float4*)db, b1 = *(const float4*)(db + 4);
            float* d = p.DT + (size_t)row * NH + (col - 9216);
            *(float4*)d = make_float4(softplus_f(va[0] + b0.x), softplus_f(va[1] + b0.y), softplus_f(va[2] + b0.z), softplus_f(va[3] + b0.w));
            *(float4*)(d + 4) = make_float4(softplus_f(vb[0] + b1.x), softplus_f(vb[1] + b1.y), softplus_f(vb[2] + b1.z), softplus_f(vb[3] + b1.w));
        }
    }
}
struct EpiG1 : EpiBaseP {
    template <int R> __device__ __forceinline__ void run(bigacc_t acc, const pg8::Unit& u, int wr, int wc, int fr, int fq) const {
        BIGP_LOOP epi_g1p<R>(*pp, L, row, col, va, vb); BIGP_END
    }
    __device__ __forceinline__ void operator()(bigacc_t acc, const pg8::Unit& u, int wr, int wc, int fr, int fq) const {
        const int pn = u.pn;
        if (pn < 4) run<0>(acc, u, wr, wc, fr, fq); else if (pn < 8) run<1>(acc, u, wr, wc, fr, fq); else if (pn < 16) run<2>(acc, u, wr, wc, fr, fq);
        else if (pn < 28) run<3>(acc, u, wr, wc, fr, fq); else if (pn < 32) run<4>(acc, u, wr, wc, fr, fq); else if (pn < 36) run<5>(acc, u, wr, wc, fr, fq);
        else run<6>(acc, u, wr, wc, fr, fq);
    }
};
struct EpiG2a : EpiBaseP {
    __device__ __forceinline__ void operator()(bigacc_t acc, const pg8::Unit& u, int wr, int wc, int fr, int fq) const {
        const P& p = *pp;
        BIGP_LOOP
            const u32x4 gu = *(const u32x4*)(p.GCM + (size_t)row * DM + col);
            st_bf8(p.MRG + (size_t)row * DM + col, va[0] * lo16(gu[0]), va[1] * hi16(gu[0]), va[2] * lo16(gu[1]), va[3] * hi16(gu[1]),
                   vb[0] * lo16(gu[2]), vb[1] * hi16(gu[2]), vb[2] * lo16(gu[3]), vb[3] * hi16(gu[3]));
        BIGP_END
    }
};
struct EpiG2b : EpiBaseP {
    __device__ __forceinline__ void operator()(bigacc_t acc, const pg8::Unit& u, int wr, int wc, int fr, int fq) const {
        const P& p = *pp;
#pragma unroll
        for (int ai = 0; ai < 2; ++ai)
#pragma unroll
            for (int m = 0; m < 4; ++m) {
                const int row = u.pm * 256 + ai * 128 + wr * 64 + m * 16 + fr;
                float s = 0.f;
#pragma unroll
                for (int j = 0; j < 8; ++j) { const float4 x = *(const float4*)(p.SSQ + (size_t)row * NH + 4 * j); s += x.x + x.y + x.z + x.w; }
                const float rstd = rsqrtf(s * (1.f / 2048.f) + EPS);
#pragma unroll
                for (int bj = 0; bj < 2; ++bj) {
                    const int col = u.pn * 256 + bj * 128 + wc * 32 + 8 * fq;
                    const f32x4 va = acc[ai][bj][m][0], vb = acc[ai][bj][m][1];
                    const u32x4 gu = *(const u32x4*)(p.GSSD + (size_t)row * DM + col);
                    const u32x4 pr = *(const u32x4*)(p.MRG + (size_t)row * DM + col);
                    st_bf8(p.MRG + (size_t)row * DM + col, lo16(pr[0]) + va[0] * rstd * lo16(gu[0]), hi16(pr[0]) + va[1] * rstd * hi16(gu[0]), lo16(pr[1]) + va[2] * rstd * lo16(gu[1]),
                           hi16(pr[1]) + va[3] * rstd * hi16(gu[1]), lo16(pr[2]) + vb[0] * rstd * lo16(gu[2]), hi16(pr[2]) + vb[1] * rstd * hi16(gu[2]),
                           lo16(pr[3]) + vb[2] * rstd * lo16(gu[3]), hi16(pr[3]) + vb[3] * rstd * hi16(gu[3]));
                }
            }
    }
};
struct EpiG3 : EpiBase {
    __device__ __forceinline__ void operator()(bigacc_t acc, const pg8::Unit& u, int wr, int wc, int fr, int fq) const {
        const P& p = *pp;
        BIG_LOOP
            const float* xr = (L == 0) ? p.x_prompt + (size_t)row * DM : p.XB + (size_t)row * DM;
            epi_res(p, L, row, col, v0, v1, v2, v3, xr, 2048);
        BIG_END
    }
};
struct EpiG5 : EpiBase {
    __device__ __forceinline__ void operator()(bigacc_t acc, const pg8::Unit& u, int wr, int wc, int fr, int fq) const {
        const P& p = *pp;
        BIG_LOOP epi_res(p, L, row, col, v0, v1, v2, v3, p.XB + (size_t)row * DM, 5120); BIG_END
    }
};
struct EpiG4 : EpiBase {
    __device__ __forceinline__ void operator()(bigacc_t acc, const pg8::Unit& u, int wr, int wc, int fr, int fq) const {
        const P& p = *pp;
#pragma unroll
        for (int ai = 0; ai < 2; ++ai)
#pragma unroll
            for (int m = 0; m < 4; ++m) {
                const int row = u.pm * 256 + ai * 128 + wr * 64 + m * 16 + fr;
#pragma unroll
                for (int bj = 0; bj < 2; ++bj) {
                    const int fc = 16 * (u.pn * 8 + bj * 4 + wc) + 4 * fq;
                    const f32x4 gt = acc[ai][bj][m][0], up = acc[ai][bj][m][1];
                    st_bf4(p.GU + (size_t)row * DFF + fc, silu_f(gt[0]) * up[0], silu_f(gt[1]) * up[1], silu_f(gt[2]) * up[2], silu_f(gt[3]) * up[3]);
                }
            }
    }
};
template <class Epi> __device__ __forceinline__ void big_gemm(const P& p, int L, const bf16_t* A, const bf16_t* Bt, int N, int K, unsigned char* smem_raw) {
    pg8::Gemm g; g.A = A; g.Bt = Bt; g.M = MPR; g.N = N; g.K = K;
    int cwg = blockIdx.x; asm volatile("" : "+s"(cwg));
    pg8::StaticOrder S; S.init(MPR, N, gridDim.x, cwg);
    Epi E; E.pp = &p; E.L = L;
    pg8::gemm_phase(( PG8_LAS unsigned char*)smem_raw, g, S, E);
}

#define SMALL_G1(R) EPI_BEGIN(acc, m0, n0) epi_g1<R>(p, L, row, col, v0, v1, v2, v3); EPI_END
__device__ void phase_g1(const P& p, int L, bf16_t* smem, unsigned char* smem_raw) {
    const bf16_t* W = p.Wt_in + (size_t)L * NIN * DM;
    big_gemm<EpiG1>(p, L, p.H, W, 9216, DM, smem_raw);
    for (int t = bidx(); t < 74; t += vgrid()) {
        const int nt = t < 73 ? t : 72, m0 = MPR, n0 = nt * 128;
        f32x16 acc[2][2]; ZERO_ACC(acc);
        gemm_mainloop(acc, p.H, DM, W, DM, DM, m0, n0, smem);
        if (nt < 8) { SMALL_G1(0) } else if (nt < 16) { SMALL_G1(1) } else if (nt < 32) { SMALL_G1(2) } else if (nt < 56) { SMALL_G1(3) }
        else if (nt < 64) { SMALL_G1(4) } else if (nt < 72) { SMALL_G1(5) } else { SMALL_G1(6) }
    }
    for (int t = (bidx() + vgrid() - 128) % vgrid(); t < 128; t += vgrid()) {
        const int m0 = t * 128, n0 = 72 * 128;
        f32x16 acc[2][2]; ZERO_ACC(acc);
        gemm_mainloop(acc, p.H, DM, W, DM, DM, m0, n0, smem);
        SMALL_G1(6)
    }
}

__device__ __forceinline__ void unpack8(const uint4 u, float (&f)[8]) {
    f[0] = lo16(u.x); f[1] = hi16(u.x); f[2] = lo16(u.y); f[3] = hi16(u.y); f[4] = lo16(u.z); f[5] = hi16(u.z); f[6] = lo16(u.w); f[7] = hi16(u.w);
}
__device__ void phase_c(const P& p, int L) {
    const int nth = vgrid() * THREADS, gt = bidx() * THREADS + tidx();
    const float* cw = p.conv_w + (size_t)L * 4 * CD;
    const float* cb = p.conv_b + (size_t)L * CD;
    for (int it = gt; it < (MPR / 16) * 384; it += nth) {
        const int rb = it / 384, j0 = (it % 384) * 8;
        const int mb = rb * 16, t0 = mb & (SEQ - 1), b = mb >> 11;
        float w[4][8], bias[8], h0[8], h1[8], h2[8];
#pragma unroll
        for (int k = 0; k < 4; ++k) { const float4 a = *(const float4*)(cw + k * CD + j0), c = *(const float4*)(cw + k * CD + j0 + 4);
            w[k][0] = a.x; w[k][1] = a.y; w[k][2] = a.z; w[k][3] = a.w; w[k][4] = c.x; w[k][5] = c.y; w[k][6] = c.z; w[k][7] = c.w; }
        { const float4 a = *(const float4*)(cb + j0), c = *(const float4*)(cb + j0 + 4); bias[0] = a.x; bias[1] = a.y; bias[2] = a.z; bias[3] = a.w; bias[4] = c.x; bias[5] = c.y; bias[6] = c.z; bias[7] = c.w; }
        if (t0 == 0) {
#pragma unroll
            for (int e = 0; e < 8; ++e) { h0[e] = 0.f; h1[e] = 0.f; h2[e] = 0.f; }
        } else {
            unpack8(*(const uint4*)(p.XBC + (size_t)(mb - 3) * CD + j0), h0);
            unpack8(*(const uint4*)(p.XBC + (size_t)(mb - 2) * CD + j0), h1);
            unpack8(*(const uint4*)(p.XBC + (size_t)(mb - 1) * CD + j0), h2);
        }
        uint4 xr16[16];
#pragma unroll
        for (int r = 0; r < 16; ++r) xr16[r] = *(const uint4*)(p.XBC + (size_t)(mb + r) * CD + j0);
#pragma unroll
        for (int r = 0; r < 16; ++r) {
            const int m = mb + r;
            float x[8], o[8];
            unpack8(xr16[r], x);
#pragma unroll
            for (int e = 0; e < 8; ++e) { o[e] = silu_f(bias[e] + w[0][e] * h0[e] + w[1][e] * h1[e] + w[2][e] * h2[e] + w[3][e] * x[e]); h0[e] = h1[e]; h1[e] = h2[e]; h2[e] = x[e]; }
            *(uint4*)(p.XC + (size_t)m * CD + j0) = make_uint4(pk2(o[0], o[1]), pk2(o[2], o[3]), pk2(o[4], o[5]), pk2(o[6], o[7]));
            const int tt = t0 + r;
            if (tt >= SEQ - 3) {
                float* d = p.out + O3 + ((size_t)(L * NB + b) * 3 + (tt - (SEQ - 3))) * CD + j0;
                *(float4*)d = make_float4(x[0], x[1], x[2], x[3]); *(float4*)(d + 4) = make_float4(x[4], x[5], x[6], x[7]);
            }
        }
    }
    for (int it = gt; it < NS * 384; it += nth) {
        const int b = it / 384, j0 = (it % 384) * 8, m = MPR + b;
        const float* sc = p.state_conv + ((size_t)(L * NS + b) * 3) * CD + j0;
        float* oc = p.out + O5 + ((size_t)(L * NS + b) * 3) * CD + j0;
        float x[8], o[8];
        unpack8(*(const uint4*)(p.XBC + (size_t)m * CD + j0), x);
#pragma unroll
        for (int e = 0; e < 8; ++e) {
            const float a0 = sc[e], a1 = sc[CD + e], a2 = sc[2 * CD + e];
            o[e] = silu_f(cb[j0 + e] + cw[j0 + e] * a0 + cw[CD + j0 + e] * a1 + cw[2 * CD + j0 + e] * a2 + cw[3 * CD + j0 + e] * x[e]);
            oc[e] = a1; oc[CD + e] = a2; oc[2 * CD + e] = x[e];
        }
        *(uint4*)(p.XC + (size_t)m * CD + j0) = make_uint4(pk2(o[0], o[1]), pk2(o[2], o[3]), pk2(o[4], o[5]), pk2(o[6], o[7]));
    }
    const int lane = tidx() & 63, gw = gt >> 6, nw = nth >> 6;
    for (int m0 = 4 * gw; m0 < MPR; m0 += 4 * nw) {
        float vv[4][16], s4[4], q4[4], mu4[4];
#pragma unroll
        for (int r = 0; r < 4; ++r) {
            const uint4 ua = *(const uint4*)(p.VG + (size_t)(m0 + r) * DM + lane * 8), ub = *(const uint4*)(p.VG + (size_t)(m0 + r) * DM + 512 + lane * 8);
            unpack8(ua, *(float(*)[8])&vv[r][0]); unpack8(ub, *(float(*)[8])&vv[r][8]);
        }
#pragma unroll
        for (int r = 0; r < 4; ++r) { s4[r] = 0.f;
#pragma unroll
            for (int e = 0; e < 16; ++e) s4[r] += vv[r][e]; }
#pragma unroll
        for (int o = 32; o > 0; o >>= 1) {
#pragma unroll
            for (int r = 0; r < 4; ++r) s4[r] += __shfl_xor(s4[r], o); }
#pragma unroll
        for (int r = 0; r < 4; ++r) { mu4[r] = s4[r] * (1.f / 1024.f); q4[r] = 0.f;
#pragma unroll
            for (int e = 0; e < 16; ++e) { const float d = vv[r][e] - mu4[r]; q4[r] += d * d; } }
#pragma unroll
        for (int o = 32; o > 0; o >>= 1) {
#pragma unroll
            for (int r = 0; r < 4; ++r) q4[r] += __shfl_xor(q4[r], o); }
        if (lane == 0) {
            *(float4*)(p.VST + 2 * m0) = make_float4(mu4[0], rsqrtf(q4[0] * (1.f / 1024.f) + EPS), mu4[1], rsqrtf(q4[1] * (1.f / 1024.f) + EPS));
            *(float4*)(p.VST + 2 * m0 + 4) = make_float4(mu4[2], rsqrtf(q4[2] * (1.f / 1024.f) + EPS), mu4[3], rsqrtf(q4[3] * (1.f / 1024.f) + EPS));
        }
    }
    for (int m = MPR + gw; m < MT; m += nw) {
        float v[16];
        unpack8(*(const uint4*)(p.VG + (size_t)m * DM + lane * 8), *(float(*)[8])&v[0]);
        unpack8(*(const uint4*)(p.VG + (size_t)m * DM + 512 + lane * 8), *(float(*)[8])&v[8]);
        float s = 0.f;
#pragma unroll
        for (int e = 0; e < 16; ++e) s += v[e];
        const float mu = wave_sum(s) * (1.f / 1024.f);
        float q = 0.f;
#pragma unroll
        for (int e = 0; e < 16; ++e) { const float d = v[e] - mu; q += d * d; }
        const float rstd = rsqrtf(wave_sum(q) * (1.f / 1024.f) + EPS);
        if (lane == 0) { p.VST[2 * m] = mu; p.VST[2 * m + 1] = rstd; }
        if (m >= MPR) {
            const int b = m - MPR;
#pragma unroll
            for (int hh = 0; hh < 2; ++hh) {
                const int c0 = hh * 512 + lane * 8, g = c0 >> 7;
                const float w00 = p.w_spatial[((size_t)(L * 8 + g) * 128) * 128], b0 = p.b_spatial[(L * 8 + g) * 128];
                float ug[8], o[8];
                unpack8(*(const uint4*)(p.UG + (size_t)m * DM + c0), ug);
#pragma unroll
                for (int e = 0; e < 8; ++e) {
                    const float ln = (v[hh * 8 + e] - mu) * rstd * p.ln_v_g[L * DM + c0 + e] + p.ln_v_b[L * DM + c0 + e];
                    p.out[O6 + (size_t)(L * NS + b) * DM + c0 + e] = ln;
                    o[e] = ug[e] * (w00 * ln + b0);
                }
                *(uint4*)(p.OCM + (size_t)m * DM + c0) = make_uint4(pk2(o[0], o[1]), pk2(o[2], o[3]), pk2(o[4], o[5]), pk2(o[6], o[7]));
            }
        }
    }
}

__device__ __forceinline__ void scan128(float v, float* out, float* tmp, int tid) {
    const int lane = tid & 63;
#pragma unroll
    for (int o = 1; o < 64; o <<= 1) { const float t = __shfl_up(v, o); if (lane >= o) v += t; }
    if (tid == 63) *tmp = v;
    __syncthreads();
    if (tid >= 64 && tid < 128) v += *tmp;
    if (tid < 128) out[tid] = v;
}

__device__ void states_task(const P& p, int L, int task, bf16_t* smem) {
    const int tid = tidx(), lane = tid & 63, wave = tid >> 6;
    const int g = task & 3, bc = task >> 2, m0 = bc * 128;
    bf16_t* BT = smem;
    bf16_t* XT = smem + 128 * TS;
    float* fa = (float*)(smem + 192 * TS);
    __syncthreads();
    {
        const int l = tid >> 1, half = tid & 1;
        const bf16_t* src = p.XC + (size_t)(m0 + l) * CD + DI + 128 * g + 64 * half;
#pragma unroll
        for (int j = 0; j < 8; ++j) {
            const uint4 u = *(const uint4*)(src + 8 * j);
            const unsigned w[4] = {u.x, u.y, u.z, u.w};
#pragma unroll
            for (int e = 0; e < 4; ++e) { BT[(64 * half + 8 * j + 2 * e) * TS + l] = (bf16_t)(w[e] & 0xffffu); BT[(64 * half + 8 * j + 2 * e + 1) * TS + l] = (bf16_t)(w[e] >> 16); }
        }
    }
    for (int e8 = 0; e8 < 8; ++e8) {
        const int h = 8 * g + e8;
        const float a = -__expf(p.a_log[L * NH + h]);
        __syncthreads();
        const float dtv = (tid < 128) ? p.DT[(size_t)(m0 + tid) * NH + h] : 0.f;
        scan128(dtv * a, fa, fa + 256, tid);
        __syncthreads();
        if (tid < 128) fa[128 + tid] = dtv * __expf(fa[127] - fa[tid]);
        __syncthreads();
        {
            const int l = tid >> 1, half = tid & 1;
            const float wl = fa[128 + l];
            const bf16_t* src = p.XC + (size_t)(m0 + l) * CD + 64 * h + 32 * half;
#pragma unroll
            for (int j = 0; j < 4; ++j) {
                float x[8]; unpack8(*(const uint4*)(src + 8 * j), x);
#pragma unroll
                for (int e = 0; e < 8; ++e) XT[(32 * half + 8 * j + e) * TS + l] = f2bf(x[e] * wl);
            }
        }
        __syncthreads();
        f32x16 acc[2];
#pragma unroll
        for (int i = 0; i < 2; ++i)
#pragma unroll
            for (int r = 0; r < 16; ++r) acc[i][r] = 0.f;
#pragma unroll
        for (int ks = 0; ks < 8; ++ks) {
            const bf16x8 bfr = *(const bf16x8*)(BT + (32 * wave + (lane & 31)) * TS + ks * 16 + (lane >> 5) * 8);
#pragma unroll
            for (int mi = 0; mi < 2; ++mi) {
                const bf16x8 af = *(const bf16x8*)(XT + (32 * mi + (lane & 31)) * TS + ks * 16 + (lane >> 5) * 8);
                acc[mi] = __builtin_amdgcn_mfma_f32_32x32x16_bf16(bfr, af, acc[mi], 0, 0, 0);
            }
        }
        float* dst = p.ST + ((size_t)(bc * NH + h) * 64) * 128;
#pragma unroll
        for (int mi = 0; mi < 2; ++mi)
#pragma unroll
            for (int q = 0; q < 4; ++q)
                *(float4*)(dst + (size_t)(32 * mi + (lane & 31)) * 128 + 32 * wave + 8 * q + 4 * (lane >> 5)) =
                    make_float4(acc[mi][4 * q], acc[mi][4 * q + 1], acc[mi][4 * q + 2], acc[mi][4 * q + 3]);
        if (tid == 0) p.CDEC[bc * NH + h] = __expf(fa[127]);
    }
}

__device__ void mix_task(const P& p, int L, int task, bf16_t* smem) {
    const int tid = tidx(), lane = tid & 63, wave = tid >> 6, wm = wave >> 1, wn = wave & 1;
    const int g = task & 7, ck = task >> 3, m0 = ck * 128;
    bf16_t* WM = smem;
    bf16_t* VT = smem + 128 * TS;
    __syncthreads();
    {
        const int i = tid >> 1, half = tid & 1;
        const float* src = p.w_spatial + ((size_t)(L * 8 + g) * 128 + i) * 128 + 64 * half;
#pragma unroll
        for (int j = 0; j < 16; ++j) {
            const float4 w = *(const float4*)(src + 4 * j);
            const int jj = 64 * half + 4 * j;
            st_bf4(WM + i * TS + jj, jj <= i ? w.x : 0.f, jj + 1 <= i ? w.y : 0.f, jj + 2 <= i ? w.z : 0.f, jj + 3 <= i ? w.w : 0.f);
        }
        const int m = m0 + i;
        const float mu = p.VST[2 * m], rstd = p.VST[2 * m + 1];
        const bf16_t* vs = p.VG + (size_t)m * DM + 128 * g + 64 * half;
        const float* gg = p.ln_v_g + L * DM + 128 * g + 64 * half;
        const float* bb = p.ln_v_b + L * DM + 128 * g + 64 * half;
#pragma unroll
        for (int j = 0; j < 8; ++j) {
            float x[8]; unpack8(*(const uint4*)(vs + 8 * j), x);
#pragma unroll
            for (int e = 0; e < 8; ++e) VT[(64 * half + 8 * j + e) * TS + i] = f2bf((x[e] - mu) * rstd * gg[8 * j + e] + bb[8 * j + e]);
        }
    }
    __syncthreads();
    f32x16 acc[2][2]; ZERO_ACC(acc);
#pragma unroll
    for (int ks = 0; ks < 8; ++ks) {
        bf16x8 af[2], bfr[2];
#pragma unroll
        for (int i = 0; i < 2; ++i) {
            af[i] = *(const bf16x8*)(WM + (wm * 64 + i * 32 + (lane & 31)) * TS + ks * 16 + (lane >> 5) * 8);
            bfr[i] = *(const bf16x8*)(VT + (wn * 64 + i * 32 + (lane & 31)) * TS + ks * 16 + (lane >> 5) * 8);
        }
#pragma unroll
        for (int mi = 0; mi < 2; ++mi)
#pragma unroll
            for (int ni = 0; ni < 2; ++ni) acc[mi][ni] = __builtin_amdgcn_mfma_f32_32x32x16_bf16(bfr[ni], af[mi], acc[mi][ni], 0, 0, 0);
    }
    const float* bs = p.b_spatial + (L * 8 + g) * 128;
    EPI_BEGIN(acc, 0, 0)
        const float bi = bs[row];
        const uint2 u = *(const uint2*)(p.UG + (size_t)(m0 + row) * DM + 128 * g + col);
        st_bf4(p.OCM + (size_t)(m0 + row) * DM + 128 * g + col, lo16(u.x) * (v0 + bi), hi16(u.x) * (v1 + bi), lo16(u.y) * (v2 + bi), hi16(u.y) * (v3 + bi));
    EPI_END
}

__device__ void sample_ssd_task(const P& p, int L, int task, float* red) {
    const int tid = tidx();
    const int h0 = (task & 15) * 2, b = task >> 4, m = MPR + b, g = h0 >> 3;
    const int n4 = (tid & 31) * 4, pb = tid >> 5;
    const bf16_t* xr = p.XC + (size_t)m * CD;
    const uint2 bu = *(const uint2*)(xr + DI + 128 * g + n4), cu = *(const uint2*)(xr + DI + 512 + 128 * g + n4);
    const float B0 = lo16(bu.x), B1 = hi16(bu.x), B2 = lo16(bu.y), B3 = hi16(bu.y);
    const float C0 = lo16(cu.x), C1 = hi16(cu.x), C2 = lo16(cu.y), C3 = hi16(cu.y);
    float dtv[2], dec[2], dsk[2];
#pragma unroll
    for (int hh = 0; hh < 2; ++hh) { dtv[hh] = p.DT[(size_t)m * NH + h0 + hh]; dec[hh] = __expf(-dtv[hh] * __expf(p.a_log[L * NH + h0 + hh])); dsk[hh] = p.d_skip[L * NH + h0 + hh]; }
    const size_t sbase = ((size_t)((L * NS + b) * NH + h0) * 64) * 128;
    float4 st[16];
#pragma unroll
    for (int i = 0; i < 16; ++i) { const f32x4 t = __builtin_nontemporal_load((const f32x4*)(p.state_ssd + sbase + (size_t)(pb + 8 * i) * 128 + n4)); st[i] = make_float4(t[0], t[1], t[2], t[3]); }
    __syncthreads();
#pragma unroll
    for (int i = 0; i < 16; ++i) {
        const int hh = i >> 3, pi = pb + 8 * (i & 7);
        const float xv = bf2f(xr[64 * (h0 + hh) + pi]), xd = xv * dtv[hh];
        const float4 hn = make_float4(st[i].x * dec[hh] + xd * B0, st[i].y * dec[hh] + xd * B1, st[i].z * dec[hh] + xd * B2, st[i].w * dec[hh] + xd * B3);
        __builtin_nontemporal_store((f32x4){hn.x, hn.y, hn.z, hn.w}, (f32x4*)(p.out + O4 + sbase + (size_t)(pb + 8 * i) * 128 + n4));
        float part = hn.x * C0 + hn.y * C1 + hn.z * C2 + hn.w * C3;
#pragma unroll
        for (int o = 16; o > 0; o >>= 1) part += __shfl_xor(part, o);
        if ((tid & 31) == 0) {
            const float y = part + dsk[hh] * xv;
            const float yg = y * bf2f(p.SZ[(size_t)m * DI + 64 * (h0 + hh) + pi]);
            p.YG[(size_t)m * DI + 64 * (h0 + hh) + pi] = f2bf(yg);
            red[64 * hh + pi] = yg * yg;
        }
    }
    __syncthreads();
    if (tid < 128) { const float s = wave_sum(red[tid]); if ((tid & 63) == 0) p.SSQ[(size_t)m * NH + h0 + (tid >> 6)] = s; }
}

constexpr int S1_STATES = NB * NCK * 4, S1_MIX = 128 * 8, S1_SAMPLE = NS * NH / 2;
__device__ void phase_s1(const P& p, int L, bf16_t* smem) {
    for (int t = bidx(); t < S1_STATES + S1_MIX + S1_SAMPLE; t += vgrid()) {
        if (t < S1_STATES) states_task(p, L, t, smem);
        else if (t < S1_STATES + S1_MIX) mix_task(p, L, t - S1_STATES, smem);
        else sample_ssd_task(p, L, t - S1_STATES - S1_MIX, (float*)smem);
    }
}

__device__ void phase_s2(const P& p, int L) {
    const int nth = vgrid() * THREADS;
    for (int it = bidx() * THREADS + tidx(); it < NB * NH * 64 * 32; it += nth) {
        const int n4 = (it & 31) * 4, pi = (it >> 5) & 63, h = (it >> 11) & 31, b = it >> 16;
        float4 hc = make_float4(0.f, 0.f, 0.f, 0.f);
#pragma unroll
        for (int c = 0; c < NCK; ++c) {
            const int bc = b * NCK + c;
            const size_t o = ((size_t)(bc * NH + h) * 64 + pi) * 128 + n4;
            const float4 s = *(const float4*)(p.ST + o);
            const float d = p.CDEC[bc * NH + h];
            st_bf4(p.ST16 + o, hc.x, hc.y, hc.z, hc.w);
            hc = make_float4(hc.x * d + s.x, hc.y * d + s.y, hc.z * d + s.z, hc.w * d + s.w);
        }
        *(float4*)(p.out + O2 + ((size_t)((L * NB + b) * NH + h) * 64 + pi) * 128 + n4) = hc;
    }
}

__device__ void ssdout_task(const P& p, int L, int task, bf16_t* smem) {
    const int tid = tidx(), lane = tid & 63, w = __builtin_amdgcn_readfirstlane(tid >> 6), hl = lane >> 5;
    const int g = task & 3, bc = task >> 2, m0 = bc * 128;
    bf16_t* R1 = smem;
    bf16_t* R2 = smem + 128 * TS;
    float* fa = (float*)(smem + 256 * TS);
    const int sx = tid >> 1, xh = tid & 1;
    const int pi = tid >> 2, nq = (tid & 3) * 32;
    u32x4 xr[4], hr[4]; float dtn;
#define S3_PREFETCH(hh)                                                                                          \
    {                                                                                                            \
        const bf16_t* _xs = p.XC + (size_t)(m0 + sx) * CD + 64 * (hh) + 32 * xh;                                 \
        _Pragma("unroll") for (int j = 0; j < 4; ++j) xr[j] = *(const u32x4*)(_xs + 8 * j);                      \
        const bf16_t* _hs = p.ST16 + ((size_t)(bc * NH + (hh)) * 64 + pi) * 128 + nq;                            \
        _Pragma("unroll") for (int j = 0; j < 4; ++j) hr[j] = *(const u32x4*)(_hs + 8 * j);                      \
        dtn = (tid < 128) ? p.DT[(size_t)(m0 + tid) * NH + (hh)] : 0.f;                                          \
    }
    __syncthreads();
    {
        const int l = tid >> 1, half = tid & 1;
        const bf16_t* src = p.XC + (size_t)(m0 + l) * CD + DI + 128 * g + 64 * half;
#pragma unroll
        for (int j = 0; j < 8; ++j) {
            *(u32x4*)(R1 + l * TS + 64 * half + 8 * j) = *(const u32x4*)(src + 512 + 8 * j);
            *(u32x4*)(R2 + l * TS + 64 * half + 8 * j) = *(const u32x4*)(src + 8 * j);
        }
    }
    __syncthreads();
    const int frag = (lane & 31) * TS + hl * 8;
    f32x16 cb[4];
#pragma unroll
    for (int i = 0; i < 4; ++i)
#pragma unroll
        for (int r = 0; r < 16; ++r) cb[i][r] = 0.f;
#pragma unroll 2
    for (int ks = 0; ks < 8; ++ks) {
        const bf16x8 cf = *(const bf16x8*)(R1 + 32 * w * TS + frag + ks * 16);
#pragma unroll
        for (int sj = 0; sj < 4; ++sj)
            if (sj <= w) {
                const bf16x8 bf = *(const bf16x8*)(R2 + 32 * sj * TS + frag + ks * 16);
                cb[sj] = __builtin_amdgcn_mfma_f32_32x32x16_bf16(bf, cf, cb[sj], 0, 0, 0);
            }
    }
    const int l = 32 * w + (lane & 31);
    float* Y = (float*)R2;
    for (int e8 = 0; e8 < 8; ++e8) {
        const int h = 8 * g + e8;
        const float a = -__expf(p.a_log[L * NH + h]), dsk = p.d_skip[L * NH + h];
        S3_PREFETCH(h)
        const float dtv = dtn;
        __syncthreads();
        if (tid < 128) fa[128 + tid] = dtv;
        scan128(dtv * a, fa, fa + 256, tid);
        {
            const float dts = fa[128 + sx];
#pragma unroll
            for (int j = 0; j < 4; ++j) {
                float x[8];
                x[0] = lo16(xr[j][0]); x[1] = hi16(xr[j][0]); x[2] = lo16(xr[j][1]); x[3] = hi16(xr[j][1]);
                x[4] = lo16(xr[j][2]); x[5] = hi16(xr[j][2]); x[6] = lo16(xr[j][3]); x[7] = hi16(xr[j][3]);
#pragma unroll
                for (int e = 0; e < 8; ++e) R2[(32 * xh + 8 * j + e) * TS + sx] = f2bf(x[e] * dts);
            }
#pragma unroll
            for (int j = 0; j < 4; ++j) *(u32x4*)(R2 + (64 + pi) * TS + nq + 8 * j) = hr[j];
        }
        unsigned warm = 0u;
        u32x4 wx[2], wh[2];
        if (e8 < 7) {
            const bf16_t* nx = p.XC + (size_t)(m0 + sx) * CD + 64 * (h + 1) + 32 * xh;
            const bf16_t* nh = p.ST16 + ((size_t)(bc * NH + h + 1) * 64 + pi) * 128 + nq;
            wx[0] = *(const u32x4*)nx; wx[1] = *(const u32x4*)(nx + 16); wh[0] = *(const u32x4*)nh; wh[1] = *(const u32x4*)(nh + 16);
        }
        u32x4 zr[4];
        {
            const bf16_t* zs = p.SZ + (size_t)(m0 + sx) * DI + 64 * h + 32 * xh;
#pragma unroll
            for (int j = 0; j < 4; ++j) zr[j] = *(const u32x4*)(zs + 8 * j);
        }
        __syncthreads();
        const float al = fa[l];
        f32x16 acc[2];
#pragma unroll
        for (int i = 0; i < 2; ++i)
#pragma unroll
            for (int r = 0; r < 16; ++r) acc[i][r] = 0.f;
#pragma unroll 2
        for (int ks = 0; ks < 8; ++ks) {
            const bf16x8 cf = *(const bf16x8*)(R1 + 32 * w * TS + frag + ks * 16);
#pragma unroll
            for (int ni = 0; ni < 2; ++ni) {
                const bf16x8 hf = *(const bf16x8*)(R2 + (64 + 32 * ni) * TS + frag + ks * 16);
                acc[ni] = __builtin_amdgcn_mfma_f32_32x32x16_bf16(hf, cf, acc[ni], 0, 0, 0);
            }
        }
        const float el = __expf(al);
#pragma unroll
        for (int i = 0; i < 2; ++i)
#pragma unroll
            for (int r = 0; r < 16; ++r) acc[i][r] *= el;
        int fo = 4 * hl, lrel = (lane & 31) - 4 * hl;
        asm volatile("" : "+v"(fo), "+v"(lrel));
        const float* fab = fa + fo;
#pragma unroll
        for (int sj = 0; sj < 4; ++sj)
            if (sj <= w) {
#pragma unroll
                for (int s2 = 0; s2 < 2; ++s2) {
                    const float4 a0 = *(const float4*)(fab + 32 * sj + 16 * s2), a1 = *(const float4*)(fab + 32 * sj + 16 * s2 + 8);
                    float pv[8] = {cb[sj][8 * s2] * __expf(al - a0.x), cb[sj][8 * s2 + 1] * __expf(al - a0.y), cb[sj][8 * s2 + 2] * __expf(al - a0.z), cb[sj][8 * s2 + 3] * __expf(al - a0.w),
                                   cb[sj][8 * s2 + 4] * __expf(al - a1.x), cb[sj][8 * s2 + 5] * __expf(al - a1.y), cb[sj][8 * s2 + 6] * __expf(al - a1.z), cb[sj][8 * s2 + 7] * __expf(al - a1.w)};
                    if (sj == w) {
#pragma unroll
                        for (int j = 0; j < 8; ++j) pv[j] = (16 * s2 + 8 * (j >> 2) + (j & 3) <= lrel) ? pv[j] : 0.f;
                    }
                    const bf16x8 pf = __builtin_bit_cast(bf16x8, ((u32x4){pk2(pv[0], pv[1]), pk2(pv[2], pv[3]), pk2(pv[4], pv[5]), pk2(pv[6], pv[7])}));
#pragma unroll
                    for (int ni = 0; ni < 2; ++ni) {
                        const bf16_t* xa = R2 + (32 * ni + (lane & 31)) * TS + 32 * sj + 16 * s2 + fo;
                        const uint2 x0 = *(const uint2*)xa, x1 = *(const uint2*)(xa + 8);
                        const bf16x8 xf = __builtin_bit_cast(bf16x8, ((u32x4){x0.x, x0.y, x1.x, x1.y}));
                        acc[ni] = __builtin_amdgcn_mfma_f32_32x32x16_bf16(xf, pf, acc[ni], 0, 0, 0);
                    }
                }
            }
        __syncthreads();
#pragma unroll
        for (int ni = 0; ni < 2; ++ni)
#pragma unroll
            for (int q = 0; q < 4; ++q)
                *(float4*)(Y + l * 68 + 32 * ni + 8 * q + 4 * hl) = make_float4(acc[ni][4 * q], acc[ni][4 * q + 1], acc[ni][4 * q + 2], acc[ni][4 * q + 3]);
        __syncthreads();
        {
            float ssq = 0.f;
            bf16_t* yo = p.YG + (size_t)(m0 + sx) * DI + 64 * h + 32 * xh;
#pragma unroll
            for (int j = 0; j < 4; ++j) {
                const float4 ya = *(const float4*)(Y + sx * 68 + 32 * xh + 8 * j), yb = *(const float4*)(Y + sx * 68 + 32 * xh + 8 * j + 4);
                const float y0 = (ya.x + dsk * lo16(xr[j][0])) * lo16(zr[j][0]), y1 = (ya.y + dsk * hi16(xr[j][0])) * hi16(zr[j][0]);
                const float y2 = (ya.z + dsk * lo16(xr[j][1])) * lo16(zr[j][1]), y3 = (ya.w + dsk * hi16(xr[j][1])) * hi16(zr[j][1]);
                const float y4 = (yb.x + dsk * lo16(xr[j][2])) * lo16(zr[j][2]), y5 = (yb.y + dsk * hi16(xr[j][2])) * hi16(zr[j][2]);
                const float y6 = (yb.z + dsk * lo16(xr[j][3])) * lo16(zr[j][3]), y7 = (yb.w + dsk * hi16(xr[j][3])) * hi16(zr[j][3]);
                *(u32x4*)(yo + 8 * j) = (u32x4){pk2(y0, y1), pk2(y2, y3), pk2(y4, y5), pk2(y6, y7)};
                ssq += y0 * y0 + y1 * y1 + y2 * y2 + y3 * y3 + y4 * y4 + y5 * y5 + y6 * y6 + y7 * y7;
                __builtin_amdgcn_sched_barrier(0);
            }
            ssq += __shfl_xor(ssq, 1);
            if (xh == 0) p.SSQ[(size_t)(m0 + sx) * NH + h] = ssq;
            if (e8 < 7) { warm = wx[0][0] ^ wx[1][0] ^ wh[0][0] ^ wh[1][0]; if (warm == 0x9e3779b9u && p.ph_hi < 0) p.SSQ[0] = 0.f; }
        }
    }
#undef S3_PREFETCH
}
__device__ void phase_s3(const P& p, int L, bf16_t* smem) {
    for (int t = bidx(); t < NB * NCK * 4; t += vgrid()) ssdout_task(p, L, t, smem);
}

__device__ void phase_g2(const P& p, int L, bf16_t* smem, unsigned char* smem_raw) {
    big_gemm<EpiG2a>(p, L, p.OCM, p.Wt_cm + (size_t)L * DM * DM, DM, DM, smem_raw);
    big_gemm<EpiG2b>(p, L, p.YG, p.Wt_ssd + (size_t)L * DM * DI, DM, DI, smem_raw);
    for (int t = bidx(); t < 8; t += vgrid()) {
        const int m0 = MPR, n0 = t * 128;
        f32x16 acc[2][2]; ZERO_ACC(acc);
        gemm_mainloop(acc, p.OCM, DM, p.Wt_cm + (size_t)L * DM * DM, DM, DM, m0, n0, smem);
        EPI_BEGIN(acc, m0, n0)
            const uint2 gu = *(const uint2*)(p.GCM + (size_t)row * DM + col);
            st_bf4(p.MRG + (size_t)row * DM + col, v0 * lo16(gu.x), v1 * hi16(gu.x), v2 * lo16(gu.y), v3 * hi16(gu.y));
        EPI_END
        ZERO_ACC(acc);
        gemm_mainloop(acc, p.YG, DI, p.Wt_ssd + (size_t)L * DM * DI, DI, DI, m0, n0, smem);
        {
            const int lane = tidx() & 63, wave = tidx() >> 6;
#pragma unroll
            for (int mi = 0; mi < 2; ++mi) {
                const int row = m0 + (wave >> 1) * 64 + mi * 32 + (lane & 31);
                float s = 0.f;
#pragma unroll
                for (int j = 0; j < 8; ++j) { const float4 x = *(const float4*)(p.SSQ + (size_t)row * NH + 4 * j); s += x.x + x.y + x.z + x.w; }
                const float rstd = rsqrtf(s * (1.f / 2048.f) + EPS);
#pragma unroll
                for (int ni = 0; ni < 2; ++ni)
#pragma unroll
                    for (int q = 0; q < 4; ++q) {
                        const int col = n0 + (wave & 1) * 64 + ni * 32 + q * 8 + (lane >> 5) * 4;
                        const uint2 gu = *(const uint2*)(p.GSSD + (size_t)row * DM + col);
                        const uint2 pr = *(const uint2*)(p.MRG + (size_t)row * DM + col);
                        st_bf4(p.MRG + (size_t)row * DM + col, lo16(pr.x) + acc[mi][ni][4 * q] * rstd * lo16(gu.x),
                               hi16(pr.x) + acc[mi][ni][4 * q + 1] * rstd * hi16(gu.x), lo16(pr.y) + acc[mi][ni][4 * q + 2] * rstd * lo16(gu.y),
                               hi16(pr.y) + acc[mi][ni][4 * q + 3] * rstd * hi16(gu.y));
                    }
            }
        }
    }
}

__device__ void phase_g3(const P& p, int L, bf16_t* smem, unsigned char* smem_raw) {
    big_gemm<EpiG3>(p, L, p.MRG, p.Wt_o + (size_t)L * DM * DM, DM, DM, smem_raw);
    for (int t = bidx(); t < 8; t += vgrid()) {
        const int m0 = MPR, n0 = t * 128;
        f32x16 acc[2][2]; ZERO_ACC(acc);
        gemm_mainloop(acc, p.MRG, DM, p.Wt_o + (size_t)L * DM * DM, DM, DM, m0, n0, smem);
        EPI_BEGIN(acc, m0, n0)
            const float* xr = (L == 0) ? p.x_sample + (size_t)(row - MPR) * DM : p.XB + (size_t)row * DM;
            epi_res(p, L, row, col, v0, v1, v2, v3, xr, 2048);
        EPI_END
    }
}

__device__ void phase_ln(const P& p, int L, int which) {
    const int lane = tidx() & 63, gw = (bidx() * THREADS + tidx()) >> 6, nw = (vgrid() * THREADS) >> 6;
    const float* gam = (which == 0 ? p.ln1_g : p.ln2_g) + L * DM;
    const float* bet = (which == 0 ? p.ln1_b : p.ln2_b) + L * DM;
    const bool last = (which == 1 && L == 1);
    constexpr int RW = 4;
    for (int m0 = RW * gw; m0 < MT; m0 += RW * nw) {
        float4 v[RW][4];
#pragma unroll
        for (int r = 0; r < RW; ++r)
#pragma unroll
            for (int j = 0; j < 4; ++j) v[r][j] = *(const float4*)(p.XB + (size_t)(m0 + r) * DM + 256 * j + 4 * lane);
        float s[RW], q[RW], mu[RW], rstd[RW];
#pragma unroll
        for (int r = 0; r < RW; ++r) { s[r] = 0.f;
#pragma unroll
            for (int j = 0; j < 4; ++j) s[r] += v[r][j].x + v[r][j].y + v[r][j].z + v[r][j].w; }
#pragma unroll
        for (int o = 32; o > 0; o >>= 1) {
#pragma unroll
            for (int r = 0; r < RW; ++r) s[r] += __shfl_xor(s[r], o); }
#pragma unroll
        for (int r = 0; r < RW; ++r) { mu[r] = s[r] * (1.f / 1024.f); q[r] = 0.f;
#pragma unroll
            for (int j = 0; j < 4; ++j) { const float a = v[r][j].x - mu[r], b = v[r][j].y - mu[r], c = v[r][j].z - mu[r], d = v[r][j].w - mu[r]; q[r] += a * a + b * b + c * c + d * d; } }
#pragma unroll
        for (int o = 32; o > 0; o >>= 1) {
#pragma unroll
            for (int r = 0; r < RW; ++r) q[r] += __shfl_xor(q[r], o); }
#pragma unroll
        for (int r = 0; r < RW; ++r) rstd[r] = rsqrtf(q[r] * (1.f / 1024.f) + EPS);
#pragma unroll
        for (int r = 0; r < RW; ++r) {
            const int m = m0 + r;
            const float* md = p.mod + (size_t)modrow(m) * MODLD + (which == 0 ? L * 6144 + 3072 : 6144);
            float* orow = last ? (m < MPR ? p.out + O0 + (size_t)m * DM : p.out + O1 + (size_t)(m - MPR) * DM) : p.XB + (size_t)m * DM;
#pragma unroll
            for (int j = 0; j < 4; ++j) {
                const int c = 256 * j + 4 * lane;
                const float4 g = *(const float4*)(gam + c), b = *(const float4*)(bet + c);
                const float4 y = make_float4((v[r][j].x - mu[r]) * rstd[r] * g.x + b.x, (v[r][j].y - mu[r]) * rstd[r] * g.y + b.y, (v[r][j].z - mu[r]) * rstd[r] * g.z + b.z, (v[r][j].w - mu[r]) * rstd[r] * g.w + b.w);
                *(float4*)(orow + c) = y;
                if (!last) {
                    const float4 sh = *(const float4*)(md + c), sc = *(const float4*)(md + 1024 + c);
                    st_bf4(p.H + (size_t)m * DM + c, y.x * (1.f + sc.x) + sh.x, y.y * (1.f + sc.y) + sh.y, y.z * (1.f + sc.z) + sh.z, y.w * (1.f + sc.w) + sh.w);
                }
            }
        }
    }
}

__device__ void phase_g4(const P& p, int L, bf16_t* smem, unsigned char* smem_raw) {
    const bf16_t* W = p.Wt_gu + (size_t)L * 2 * DFF * DM;
    big_gemm<EpiG4>(p, L, p.H, W, 2 * DFF, DM, smem_raw);
    for (int t = (bidx() + vgrid() - 256) % vgrid(); t < 44; t += vgrid()) {
        const int nt = t, m0 = MPR, n0 = nt * 128;
        f32x16 acc[2][2]; ZERO_ACC(acc);
        gemm_mainloop(acc, p.H, DM, W, DM, DM, m0, n0, smem);
        const int lane = tidx() & 63, wave = tidx() >> 6;
#pragma unroll
        for (int mi = 0; mi < 2; ++mi) {
            const int row = m0 + (wave >> 1) * 64 + mi * 32 + (lane & 31);
#pragma unroll
            for (int ni = 0; ni < 2; ++ni)
#pragma unroll
                for (int q = 0; q < 2; ++q) {
                    const int fc = 16 * (nt * 4 + (wave & 1) * 2 + ni) + q * 8 + (lane >> 5) * 4;
                    st_bf4(p.GU + (size_t)row * DFF + fc, silu_f(acc[mi][ni][4 * q]) * acc[mi][ni][8 + 4 * q], silu_f(acc[mi][ni][4 * q + 1]) * acc[mi][ni][8 + 4 * q + 1],
                           silu_f(acc[mi][ni][4 * q + 2]) * acc[mi][ni][8 + 4 * q + 2], silu_f(acc[mi][ni][4 * q + 3]) * acc[mi][ni][8 + 4 * q + 3]);
                }
        }
    }
}

__device__ void phase_g5(const P& p, int L, bf16_t* smem, unsigned char* smem_raw) {
    big_gemm<EpiG5>(p, L, p.GU, p.Wt_d + (size_t)L * DM * DFF, DM, DFF, smem_raw);
    for (int t = bidx(); t < 8; t += vgrid()) {
        const int m0 = MPR, n0 = t * 128;
        f32x16 acc[2][2]; ZERO_ACC(acc);
        gemm_mainloop(acc, p.GU, DFF, p.Wt_d + (size_t)L * DM * DFF, DFF, DFF, m0, n0, smem);
        EPI_BEGIN(acc, m0, n0) epi_res(p, L, row, col, v0, v1, v2, v3, p.XB + (size_t)row * DM, 5120); EPI_END
    }
}

#define XB_TMO      128
#define XB_XCNT(j)  (256  + 64 * (j))
#define XB_XSUB(j)  (1280 + 64 * (j))
#define XB_XGEN(j)  (2304 + 64 * (j))
#define XB_TOP      3328
#define XB_TOPGEN   3392
#define XCD_BAR_WORDS 3456
#define XB_SPIN_CAP (1u << 22)
#define LAS __attribute__((address_space(3)))
__device__ __forceinline__ unsigned xb_ld(unsigned* p)              { return __hip_atomic_load(p, __ATOMIC_RELAXED, __HIP_MEMORY_SCOPE_AGENT); }
__device__ __forceinline__ unsigned xb_add(unsigned* p, unsigned v) { return __hip_atomic_fetch_add(p, v, __ATOMIC_RELAXED, __HIP_MEMORY_SCOPE_AGENT); }
__device__ __forceinline__ unsigned xb_xcc_id() { return (unsigned)__builtin_amdgcn_s_getreg((3 << 11) | 20) & 0xFu; }
#define XB_SPIN(cond, bar) do { unsigned _sp = 0; while (cond) { __builtin_amdgcn_s_sleep(1); \
    if ((++_sp & 255u) == 0u) { if (xb_ld(&(bar)[XB_TMO])) break; if (_sp > XB_SPIN_CAP) { atomicAdd(&(bar)[XB_TMO], 1u); break; } } } } while (0)
struct XcdBarrier { unsigned* bar; unsigned x; volatile LAS unsigned* st; };
__device__ __forceinline__ XcdBarrier xcd_barrier_post(unsigned* bar, volatile LAS unsigned* st) {
    XcdBarrier b; b.bar = bar; b.x = xb_xcc_id(); b.st = st;
    if (threadIdx.x == 0) (void)xb_add(&bar[XB_XCNT(b.x)], 1u);
    return b;
}
__device__ __forceinline__ void xcd_barrier_complete(unsigned* bar, unsigned x, unsigned& nloc, unsigned& nx) {
    const unsigned G = gridDim.x * gridDim.y * gridDim.z;
    unsigned sum, cnt, mine, sp = 0u;
    for (;;) {
        sum = 0u; cnt = 0u; mine = 0u;
#pragma unroll
        for (unsigned j = 0; j < 16; ++j) { const unsigned c = xb_ld(&bar[XB_XCNT(j)]); sum += c; cnt += (c > 0u) ? 1u : 0u; mine = (j == x) ? c : mine; }
        if (sum == G) break;
        __builtin_amdgcn_s_sleep(1);
        if ((++sp & 255u) == 0u) { if (xb_ld(&bar[XB_TMO])) break; if (sp > XB_SPIN_CAP) { atomicAdd(&bar[XB_TMO], 1u); break; } }
    }
    nloc = mine > 0u ? mine : 1u; nx = cnt > 0u ? cnt : 1u;
}
__device__ __forceinline__ void xcd_barrier(const XcdBarrier& b) {
    asm volatile("s_waitcnt vmcnt(0)" ::: "memory");
    __syncthreads();
    int t0 = threadIdx.x; asm volatile("" : "+v"(t0));
    if (t0 == 0) {
        unsigned* bar = b.bar;
        __builtin_amdgcn_s_waitcnt(0);
        unsigned nloc = b.st[0], nx = b.st[1];
        if (nloc == 0u) { xcd_barrier_complete(bar, b.x, nloc, nx); b.st[0] = nloc; b.st[1] = nx; }
        const unsigned old = xb_add(&bar[XB_XSUB(b.x)], 1u);
        const unsigned gen = old / nloc;
        if (old + 1u == (gen + 1u) * nloc) {
            __builtin_amdgcn_fence(__ATOMIC_RELEASE, "agent");
            asm volatile("s_waitcnt vmcnt(0)" ::: "memory");
            const unsigned og = xb_add(&bar[XB_TOP], 1u);
            const unsigned tg = og / nx;
            if (og + 1u == (tg + 1u) * nx) xb_add(&bar[XB_TOPGEN], 1u);
            else XB_SPIN(xb_ld(&bar[XB_TOPGEN]) == tg, bar);
            __builtin_amdgcn_fence(__ATOMIC_ACQUIRE, "agent");
            xb_add(&bar[XB_XGEN(b.x)], 1u);
            asm volatile("s_waitcnt vmcnt(0)" ::: "memory");
        } else {
            XB_SPIN(xb_ld(&bar[XB_XGEN(b.x)]) == gen, bar);
            __builtin_amdgcn_fence(__ATOMIC_ACQUIRE, "agent");
            asm volatile("s_waitcnt vmcnt(0)" ::: "memory");
        }
    }
    __syncthreads();
}

constexpr int N_PHASES = 3 + 2 * 11;
__global__ void __launch_bounds__(BLOCK, 2) fwd_kernel(P p) {
    extern __shared__ __attribute__((aligned(16))) unsigned char smem_raw[];
    bf16_t* smem = (bf16_t*)(smem_raw + vhalf() * HALF_LDS);
    __shared__ uint4 xb_words;
    if (threadIdx.x == 0) xb_words = make_uint4(0u, 0u, 0u, 0u);
    __syncthreads();
    const XcdBarrier xb = xcd_barrier_post(p.bar, (volatile LAS unsigned*)&xb_words);
    phase_w(p, (float*)smem);
    if (p.ph_hi < 0) cg::this_grid().sync();
    xcd_barrier(xb);
    for (int ph = 1; ph < p.ph_hi; ++ph) {
        if (ph == 1) phase_ada(p, smem);
        else if (ph == 2) phase_e0(p);
        else {
            const int L = (ph - 3) / 11, s = (ph - 3) % 11;
            switch (s) {
                case 0: phase_g1(p, L, smem, smem_raw); break;
                case 1: phase_c(p, L); break;
                case 2: phase_s1(p, L, smem); break;
                case 3: phase_s2(p, L); break;
                case 4: phase_s3(p, L, smem); break;
                case 5: phase_g2(p, L, smem, smem_raw); break;
                case 6: phase_g3(p, L, smem, smem_raw); break;
                case 7: phase_ln(p, L, 0); break;
                case 8: phase_g4(p, L, smem, smem_raw); break;
                case 9: phase_g5(p, L, smem, smem_raw); break;
                default: phase_ln(p, L, 1); break;
            }
        }
        if (ph + 1 < p.ph_hi) xcd_barrier(xb);
    }
}

extern "C" void kernel_launch(void* const* d_in, const int* in_sizes, int n_in, void* d_out, int out_size, void* d_ws, size_t ws_size, hipStream_t stream) {
    static int grid = 0;
    if (grid == 0) {
        int dev = 0, cus = 0, per_cu = 0;
        (void)hipGetDevice(&dev);
        (void)hipDeviceGetAttribute(&cus, hipDeviceAttributeMultiprocessorCount, dev);
        (void)hipFuncSetAttribute((const void*)fwd_kernel, hipFuncAttributeMaxDynamicSharedMemorySize, LDS_BYTES);
        (void)hipOccupancyMaxActiveBlocksPerMultiprocessor(&per_cu, (const void*)fwd_kernel, BLOCK, LDS_BYTES);
        if (per_cu != 1) per_cu = 1;
        grid = cus * per_cu;
        fprintf(stderr, "kernel_launch: cus %d per_cu %d grid %d\n", cus, per_cu, grid);
    }
    P p{};
    const float** ip = (const float**)&p;
    for (int i = 0; i < 30; ++i) ip[i] = (const float*)d_in[i];
    p.out = (float*)d_out;
    unsigned char* w = (unsigned char*)d_ws;
    size_t off = 0;
    auto take = [&](size_t bytes) { unsigned char* r = w + off; off += (bytes + 255) & ~(size_t)255; return r; };
    p.Wt_in = (bf16_t*)take((size_t)2 * NIN * DM * 2);
    p.Wt_cm = (bf16_t*)take((size_t)2 * DM * DM * 2);
    p.Wt_ssd = (bf16_t*)take((size_t)2 * DM * DI * 2);
    p.Wt_o = (bf16_t*)take((size_t)2 * DM * DM * 2);
    p.Wt_gu = (bf16_t*)take((size_t)2 * 2 * DFF * DM * 2);
    p.Wt_d = (bf16_t*)take((size_t)2 * DM * DFF * 2);
    p.Wt_ada = (bf16_t*)take((size_t)2 * 6144 * DM * 2);
    p.SC = (bf16_t*)take((size_t)256 * DM * 2);
    p.mod = (float*)take((size_t)NMOD * MODLD * 4);
    p.XB = (float*)take((size_t)MT * DM * 4);
    p.H = (bf16_t*)take((size_t)MT * DM * 2);
    p.DT = (float*)take((size_t)MT * NH * 4);
    p.VST = (float*)take((size_t)MT * 2 * 4);
    p.ST = (float*)take((size_t)NB * NCK * NH * 64 * 128 * 4);
    p.CDEC = (float*)take((size_t)NB * NCK * NH * 4);
    p.ST16 = (bf16_t*)take((size_t)NB * NCK * NH * 64 * 128 * 2);
    p.SSQ = (float*)take((size_t)MT * NH * 4);
    p.UG = (bf16_t*)take((size_t)MT * DM * 2);
    p.VG = (bf16_t*)take((size_t)MT * DM * 2);
    p.SZ = (bf16_t*)take((size_t)MT * DI * 2);
    p.GU = p.UG;
    p.XBC = (bf16_t*)take((size_t)MT * CD * 2);
    p.GCM = (bf16_t*)take((size_t)MT * DM * 2);
    p.GSSD = (bf16_t*)take((size_t)MT * DM * 2);
    p.XC = (bf16_t*)take((size_t)MT * CD * 2);
    p.OCM = (bf16_t*)take((size_t)MT * DM * 2);
    p.YG = (bf16_t*)take((size_t)MT * DI * 2);
    p.MRG = (bf16_t*)take((size_t)MT * DM * 2);
    p.bar = (unsigned*)take((size_t)XCD_BAR_WORDS * 4);
    if (off > ws_size) { fprintf(stderr, "kernel_launch: workspace too small: need %zu have %zu\n", off, ws_size); return; }
    p.ph_lo = 0; p.ph_hi = N_PHASES; p.coop = 1;
    (void)hipMemsetAsync(p.bar, 0, (size_t)XCD_BAR_WORDS * 4, stream);
    void* args[] = {&p};
    hipError_t e = hipLaunchCooperativeKernel((const void*)fwd_kernel, dim3(grid), dim3(BLOCK), args, LDS_BYTES, stream);
    if (e != hipSuccess) fprintf(stderr, "cooperative launch failed: %s (grid %d)\n", hipGetErrorString(e), grid);
}
```

```cpp
#include <hip/hip_runtime.h>
#include <hip/hip_cooperative_groups.h>
#include <cstdio>
namespace cg = cooperative_groups;

#ifndef REP_W
#define REP_W 1
#define REP_G1 1
#define REP_C 1
#define REP_S1 1
#define REP_S3 1
#define REP_G2 1
#define REP_G4 1
#endif
#ifndef MK_ONE_LAUNCH
#define MK_ONE_LAUNCH 1
#endif

typedef unsigned short bf16_t;
typedef short bf16x8 __attribute__((ext_vector_type(8)));
typedef float f32x16 __attribute__((ext_vector_type(16)));
typedef float f32x4 __attribute__((ext_vector_type(4)));
typedef unsigned u32x4 __attribute__((ext_vector_type(4)));

constexpr int DM = 1024, NB = 8, SEQ = 2048, MPR = NB * SEQ, NS = 128, MT = MPR + NS;
constexpr int DI = 2048, CD = 3072, NH = 32, DFF = 2816, NIN = 9472, NCK = 16;
constexpr int MODLD = 12288, NMOD = 136;
constexpr float ALPHA = 1.41421356237309515f;
constexpr float EPS = 1e-5f;
constexpr int THREADS = 256;
constexpr int BLOCK = 512;
constexpr int GS = 72;
constexpr int GT = 128 * GS;
constexpr int TS = 136;
constexpr int HALF_LDS = 4 * GT * 2;
constexpr int LDS_BYTES = 2 * HALF_LDS;

constexpr size_t O0 = 0, O1 = O0 + (size_t)MPR * DM, O2 = O1 + (size_t)NS * DM, O3 = O2 + (size_t)2 * NB * NH * 64 * 128,
                 O4 = O3 + (size_t)2 * NB * 3 * CD, O5 = O4 + (size_t)2 * NS * NH * 64 * 128, O6 = O5 + (size_t)2 * NS * 3 * CD;

struct P {
    const float *x_prompt, *x_sample, *state_ssd, *state_conv, *c_prompt, *c_sample, *w_ada, *b_ada, *w_in, *b_gate, *ln_v_g, *ln_v_b, *w_spatial,
        *b_spatial, *conv_w, *conv_b, *dt_bias, *a_log, *d_skip, *ssd_norm_w, *w_cm_br, *w_ssd_br, *w_o, *ln1_g, *ln1_b, *w_ffn_gate, *w_ffn_up,
        *w_ffn_down, *ln2_g, *ln2_b;
    float* out;
    bf16_t *Wt_in, *Wt_cm, *Wt_ssd, *Wt_o, *Wt_gu, *Wt_d, *Wt_ada, *SC;
    float *mod, *XB, *DT, *VST, *ST, *CDEC, *SSQ;
    bf16_t *H, *UG, *VG, *SZ, *XBC, *GCM, *GSSD, *XC, *OCM, *YG, *MRG, *GU, *ST16;
    unsigned* bar;
    int ph_lo, ph_hi, coop, pad;
};

__device__ __forceinline__ float bf2f(unsigned h) { return __uint_as_float(h << 16); }
__device__ __forceinline__ unsigned pk2(float lo, float hi) { unsigned r; asm("v_cvt_pk_bf16_f32 %0, %1, %2" : "=v"(r) : "v"(lo), "v"(hi)); return r; }
__device__ __forceinline__ bf16_t f2bf(float f) { return (bf16_t)(pk2(f, 0.f) & 0xffffu); }
__device__ __forceinline__ float lo16(unsigned u) { return __uint_as_float(u << 16); }
__device__ __forceinline__ float hi16(unsigned u) { return __uint_as_float(u & 0xffff0000u); }
__device__ __forceinline__ float sigmoid_f(float x) { return __builtin_amdgcn_rcpf(1.f + __builtin_amdgcn_exp2f(x * -1.44269504089f)); }
__device__ __forceinline__ float silu_f(float x) { return x * sigmoid_f(x); }
__device__ __forceinline__ float gelu_f(float v) {
    const float av = fabsf(v), t = __builtin_amdgcn_rcpf(av * 0.2316418882f + 1.0f);
    float q = t * 0.5307027145f + (-0.7265760135f); q = q * t + 0.7107068705f; q = q * t + (-0.142248368f); q = q * t + 0.127414796f; q = q * t;
    const float e = __builtin_amdgcn_exp2f((v * v) * (-0.72134752044f));
    const float m = v * (q * e);
    return v < 0.f ? m : v - m;
}
typedef float f32x2 __attribute__((ext_vector_type(2)));
__device__ __forceinline__ f32x2 gelu_pk2(float a, float b) { return (f32x2){gelu_f(a), gelu_f(b)}; }
__device__ __forceinline__ float softplus_f(float x) { return fmaxf(x, 0.f) + __logf(1.f + __expf(-fabsf(x))); }
__device__ __forceinline__ int modrow(int m) { return m < MPR ? (m >> 11) : (NB + m - MPR); }
__device__ __forceinline__ float wave_sum(float v) {
#pragma unroll
    for (int o = 32; o > 0; o >>= 1) v += __shfl_xor(v, o);
    return v;
}

__device__ __forceinline__ int tidx() { int t = threadIdx.x & 255; asm volatile("" : "+v"(t)); return t; }
__device__ __forceinline__ int vhalf() { return __builtin_amdgcn_readfirstlane((int)(threadIdx.x >> 8)); }
__device__ __forceinline__ int bidx() { int b = 2 * blockIdx.x + vhalf(); asm volatile("" : "+s"(b)); return b; }
__device__ __forceinline__ int vgrid() { return 2 * gridDim.x; }

__device__ __forceinline__ void gemm_mainloop(f32x16 (&acc)[2][2], const bf16_t* __restrict__ A, int lda, const bf16_t* __restrict__ Bt, int ldb,
                                              int K, int m0, int n0, bf16_t* smem) {
    const int tid = tidx(), lane = tid & 63, wave = tid >> 6, wm = wave >> 1, wn = wave & 1;
    const int lr = tid >> 3, lc = (tid & 7) * 8;
    const bf16_t* Ap = A + (size_t)(m0 + lr) * lda + lc;
    const bf16_t* Bp = Bt + (size_t)(n0 + lr) * ldb + lc;
    u32x4 ra0, ra1, ra2, ra3, rb0, rb1, rb2, rb3, sa0, sa1, sa2, sa3, sb0, sb1, sb2, sb3;
#define G_LOAD(A0, A1, A2, A3, B0, B1, B2, B3, koff)                                           \
    A0 = *(const u32x4*)(Ap + (koff)); A1 = *(const u32x4*)(Ap + (size_t)32 * lda + (koff));   \
    A2 = *(const u32x4*)(Ap + (size_t)64 * lda + (koff)); A3 = *(const u32x4*)(Ap + (size_t)96 * lda + (koff)); \
    B0 = *(const u32x4*)(Bp + (koff)); B1 = *(const u32x4*)(Bp + (size_t)32 * ldb + (koff));   \
    B2 = *(const u32x4*)(Bp + (size_t)64 * ldb + (koff)); B3 = *(const u32x4*)(Bp + (size_t)96 * ldb + (koff));
#define G_STORE(D, A0, A1, A2, A3, B0, B1, B2, B3)                                    \
    *(u32x4*)((D) + lr * GS + lc) = A0; *(u32x4*)((D) + (lr + 32) * GS + lc) = A1;    \
    *(u32x4*)((D) + (lr + 64) * GS + lc) = A2; *(u32x4*)((D) + (lr + 96) * GS + lc) = A3; \
    *(u32x4*)((D) + GT + lr * GS + lc) = B0; *(u32x4*)((D) + GT + (lr + 32) * GS + lc) = B1; \
    *(u32x4*)((D) + GT + (lr + 64) * GS + lc) = B2; *(u32x4*)((D) + GT + (lr + 96) * GS + lc) = B3;
#define G_COMPUTE(S)                                                                                                       \
    _Pragma("unroll") for (int ks = 0; ks < 4; ++ks) {                                                                     \
        const bf16x8 af0 = *(const bf16x8*)((S) + aoff + ks * 16), af1 = *(const bf16x8*)((S) + aoff + 32 * GS + ks * 16); \
        const bf16x8 bf0 = *(const bf16x8*)((S) + boff + ks * 16), bf1 = *(const bf16x8*)((S) + boff + 32 * GS + ks * 16); \
        acc[0][0] = __builtin_amdgcn_mfma_f32_32x32x16_bf16(bf0, af0, acc[0][0], 0, 0, 0);                                 \
        acc[0][1] = __builtin_amdgcn_mfma_f32_32x32x16_bf16(bf1, af0, acc[0][1], 0, 0, 0);                                 \
        acc[1][0] = __builtin_amdgcn_mfma_f32_32x32x16_bf16(bf0, af1, acc[1][0], 0, 0, 0);                                 \
        acc[1][1] = __builtin_amdgcn_mfma_f32_32x32x16_bf16(bf1, af1, acc[1][1], 0, 0, 0);                                 \
    }
    const int nk = K >> 6;
    const int aoff = (wm * 64 + (lane & 31)) * GS + (lane >> 5) * 8;
    const int boff = GT + (wn * 64 + (lane & 31)) * GS + (lane >> 5) * 8;
    G_LOAD(ra0, ra1, ra2, ra3, rb0, rb1, rb2, rb3, 0)
    { const int k1 = (nk > 1) ? 64 : 0; G_LOAD(sa0, sa1, sa2, sa3, sb0, sb1, sb2, sb3, k1) }
    __syncthreads();
    G_STORE(smem, ra0, ra1, ra2, ra3, rb0, rb1, rb2, rb3)
    __syncthreads();
    bf16_t* S0 = smem; bf16_t* S1 = smem + 2 * GT;
    for (int kt = 0; kt < nk; kt += 2) {
        { const int kn = (kt + 2 < nk ? kt + 2 : nk - 1) * 64; G_LOAD(ra0, ra1, ra2, ra3, rb0, rb1, rb2, rb3, kn) }
        G_COMPUTE(S0)
        if (kt + 1 < nk) { G_STORE(S1, sa0, sa1, sa2, sa3, sb0, sb1, sb2, sb3) }
        __syncthreads();
        if (kt + 1 >= nk) break;
        { const int kn = (kt + 3 < nk ? kt + 3 : nk - 1) * 64; G_LOAD(sa0, sa1, sa2, sa3, sb0, sb1, sb2, sb3, kn) }
        G_COMPUTE(S1)
        if (kt + 2 < nk) { G_STORE(S0, ra0, ra1, ra2, ra3, rb0, rb1, rb2, rb3) }
        __syncthreads();
    }
#undef G_LOAD
#undef G_STORE
#undef G_COMPUTE
}

#define ZERO_ACC(acc)                                      \
    _Pragma("unroll") for (int _i = 0; _i < 2; ++_i)       \
        _Pragma("unroll") for (int _j = 0; _j < 2; ++_j)   \
            _Pragma("unroll") for (int _r = 0; _r < 16; ++_r) acc[_i][_j][_r] = 0.f;

__device__ __forceinline__ void gemm_ksplit(f32x16 (&acc)[2][2], const bf16_t* __restrict__ A, int lda, const bf16_t* __restrict__ Bt, int ldb, int K, int m0, int n0,
                                            bf16_t* smem, unsigned char* smem_raw) {
    const int vh = vhalf(), kh = K >> 1, tid = tidx();
    gemm_mainloop(acc, A + vh * kh, lda, Bt + vh * kh, ldb, kh, m0, n0, smem);
    float* red = (float*)(smem_raw + HALF_LDS);
    if (vh == 1) {
#pragma unroll
        for (int b = 0; b < 4; ++b)
#pragma unroll
            for (int r = 0; r < 16; ++r) red[(b * 16 + r) * 256 + tid] = acc[b >> 1][b & 1][r];
    }
    __syncthreads();
    if (vh == 0) {
#pragma unroll
        for (int b = 0; b < 4; ++b)
#pragma unroll
            for (int r = 0; r < 16; ++r) acc[b >> 1][b & 1][r] += red[(b * 16 + r) * 256 + tid];
    }
    __syncthreads();
}

#define EPI_BEGIN(acc, m0, n0)                                                                                     \
    {                                                                                                              \
        const int _lane = tidx() & 63, _wave = tidx() >> 6;                                              \
        _Pragma("unroll") for (int _mi = 0; _mi < 2; ++_mi) {                                                      \
            const int row = (m0) + (_wave >> 1) * 64 + _mi * 32 + (_lane & 31);                                    \
            _Pragma("unroll") for (int _ni = 0; _ni < 2; ++_ni) _Pragma("unroll") for (int _q = 0; _q < 4; ++_q) { \
                const int col = (n0) + (_wave & 1) * 64 + _ni * 32 + _q * 8 + (_lane >> 5) * 4;                    \
                float v0 = acc[_mi][_ni][4 * _q], v1 = acc[_mi][_ni][4 * _q + 1], v2 = acc[_mi][_ni][4 * _q + 2], v3 = acc[_mi][_ni][4 * _q + 3];
#define EPI_END \
    }           \
    }           \
    }

__device__ __forceinline__ void st_bf4(bf16_t* p, float a, float b, float c, float d) { *(uint2*)p = make_uint2(pk2(a, b), pk2(c, d)); }

__device__ void cvt_tile(const float* __restrict__ src, const float* __restrict__ src2, const float* __restrict__ kscale, bf16_t* __restrict__ dst, int K,
                         int Nsrc, int mode, int tk, int tn, float* tile) {
    const int tid = tidx(), nn = (tid & 15) * 4, kb = tid >> 4;
    const int np = tn * 64 + nn;
    const float* s = src; int n = np; bool valid = true;
    if (mode == 1) { if (np < 7168) n = np; else if (np < 9216) n = np + 32; else if (np < 9248) n = np - 2048; else { valid = false; n = 0; } }
    else if (mode == 2) { const int q = np >> 5, r = np & 31; n = q * 16 + (r & 15); s = (r < 16) ? src : src2; }
    __syncthreads();
#pragma unroll
    for (int i = 0; i < 4; ++i) {
        const int k = tk * 64 + kb + 16 * i;
        float4 v = make_float4(0.f, 0.f, 0.f, 0.f);
        if (valid) { const f32x4 t = __builtin_nontemporal_load((const f32x4*)(s + (size_t)k * Nsrc + n)); v = make_float4(t[0], t[1], t[2], t[3]); }
        if (kscale) { const float sc = kscale[k]; v.x *= sc; v.y *= sc; v.z *= sc; v.w *= sc; }
        float* t = tile + (kb + 16 * i) * 65 + nn;
        t[0] = v.x; t[1] = v.y; t[2] = v.z; t[3] = v.w;
    }
    __syncthreads();
    const int orow = tid >> 2, kc = (tid & 3) * 16;
    unsigned w[8];
#pragma unroll
    for (int j = 0; j < 8; ++j) w[j] = pk2(tile[(kc + 2 * j) * 65 + orow], tile[(kc + 2 * j + 1) * 65 + orow]);
    bf16_t* d = dst + (size_t)(tn * 64 + orow) * K + tk * 64 + kc;
    *(uint4*)d = make_uint4(w[0], w[1], w[2], w[3]);
    *(uint4*)(d + 8) = make_uint4(w[4], w[5], w[6], w[7]);
}

constexpr int CT_IN = 16 * 148, CT_CM = 256, CT_SSD = 32 * 16, CT_O = 256, CT_GU = 16 * 88, CT_D = 44 * 16, CT_ADA = 16 * 96;
constexpr int CT_LAYER = CT_IN + CT_CM + CT_SSD + CT_O + CT_GU + CT_D + CT_ADA;
constexpr int CT_ALL = 2 * CT_LAYER, SC_TASKS = 64;

__device__ void phase_w(const P& p, float* smemf) {
    for (int t = bidx(); t < CT_ALL + SC_TASKS; t += vgrid()) {
        if (t >= CT_ALL) {
            const int base = (t - CT_ALL) * 4096;
#pragma unroll
            for (int i = 0; i < 16; ++i) {
                const int e = base + i * 256 + tidx(), r = e >> 10, k = e & 1023;
                float v = 0.f;
                if (r < NB) v = silu_f(p.c_prompt[r * DM + k]); else if (r < NMOD) v = silu_f(p.c_sample[(r - NB) * DM + k]);
                p.SC[e] = f2bf(v);
            }
            continue;
        }
        const int L = t / CT_LAYER; int r = t % CT_LAYER;
        if (r < CT_IN) { cvt_tile(p.w_in + (size_t)L * DM * 9248, nullptr, nullptr, p.Wt_in + (size_t)L * NIN * DM, DM, 9248, 1, r % 16, r / 16, smemf); continue; }
        r -= CT_IN;
        if (r < CT_CM) { cvt_tile(p.w_cm_br + (size_t)L * DM * DM, nullptr, nullptr, p.Wt_cm + (size_t)L * DM * DM, DM, DM, 0, r % 16, r / 16, smemf); continue; }
        r -= CT_CM;
        if (r < CT_SSD) { cvt_tile(p.w_ssd_br + (size_t)L * DI * DM, nullptr, p.ssd_norm_w + L * DI, p.Wt_ssd + (size_t)L * DM * DI, DI, DM, 0, r % 32, r / 32, smemf); continue; }
        r -= CT_SSD;
        if (r < CT_O) { cvt_tile(p.w_o + (size_t)L * DM * DM, nullptr, nullptr, p.Wt_o + (size_t)L * DM * DM, DM, DM, 0, r % 16, r / 16, smemf); continue; }
        r -= CT_O;
        if (r < CT_GU) { cvt_tile(p.w_ffn_gate + (size_t)L * DM * DFF, p.w_ffn_up + (size_t)L * DM * DFF, nullptr, p.Wt_gu + (size_t)L * 2 * DFF * DM, DM, DFF, 2, r % 16, r / 16, smemf); continue; }
        r -= CT_GU;
        if (r < CT_D) { cvt_tile(p.w_ffn_down + (size_t)L * DFF * DM, nullptr, nullptr, p.Wt_d + (size_t)L * DM * DFF, DFF, DM, 0, r % 44, r / 44, smemf); continue; }
        r -= CT_D;
        cvt_tile(p.w_ada + (size_t)L * DM * 6144, nullptr, nullptr, p.Wt_ada + (size_t)L * 6144 * DM, DM, 6144, 0, r % 16, r / 16, smemf);
    }
}

__device__ void phase_ada(const P& p, bf16_t* smem) {
    for (int t = bidx(); t < 2 * 96; t += vgrid()) {
        const int m0 = (t / 96) * 128, n0 = (t % 96) * 128;
        f32x16 acc[2][2]; ZERO_ACC(acc);
        gemm_mainloop(acc, p.SC, DM, p.Wt_ada, DM, DM, m0, n0, smem);
        EPI_BEGIN(acc, m0, n0)
            if (row < NMOD) {
                const float4 b = *(const float4*)(p.b_ada + col);
                *(float4*)(p.mod + (size_t)row * MODLD + col) = make_float4(v0 + b.x, v1 + b.y, v2 + b.z, v3 + b.w);
            }
        EPI_END
    }
}

__device__ void phase_e0(const P& p) {
    const int nth = vgrid() * THREADS;
    for (int i0 = bidx() * THREADS + tidx(); i0 < MT * 256; i0 += 4 * nth) {
        float4 x[4], sh[4], sc[4];
#pragma unroll
        for (int u = 0; u < 4; ++u) {
            const int i = i0 + u * nth;
            if (i < MT * 256) {
                const int m = i >> 8, k4 = (i & 255) * 4;
                const float* xr = m < MPR ? p.x_prompt + (size_t)m * DM : p.x_sample + (size_t)(m - MPR) * DM;
                const float* md = p.mod + (size_t)modrow(m) * MODLD;
                x[u] = *(const float4*)(xr + k4); sh[u] = *(const float4*)(md + k4); sc[u] = *(const float4*)(md + 1024 + k4);
            }
        }
#pragma unroll
        for (int u = 0; u < 4; ++u) {
            const int i = i0 + u * nth;
            if (i < MT * 256) {
                const int m = i >> 8, k4 = (i & 255) * 4;
                st_bf4(p.H + (size_t)m * DM + k4, x[u].x * (1.f + sc[u].x) + sh[u].x, x[u].y * (1.f + sc[u].y) + sh[u].y, x[u].z * (1.f + sc[u].z) + sh[u].z, x[u].w * (1.f + sc[u].w) + sh[u].w);
            }
        }
    }
}

#define PG8_LAS __attribute__((address_space(3)))
typedef float f32x4 __attribute__((ext_vector_type(4)));
namespace pg8 {
constexpr int BM = 256, BK = 64, HALF = 128, HTB = HALF * BK * 2, NXCD = 8, WGM = 8;
__device__ __forceinline__ int lds_byte(int r, int c) { const int st = (r >> 4) * 2 + (c >> 5), rr = r & 15, cc = c & 31, ob = rr * 64 + cc * 2; return st * 1024 + (ob ^ (((ob >> 9) & 1) << 5)); }
__device__ __forceinline__ int perm32(int rho) { const int n = rho >> 4, i = rho & 15; return 8 * (i >> 2) + 4 * n + (i & 3); }
__device__ __forceinline__ void stage_rc(int b, int& R, int& C) { const int st = b / 1024, sb = b % 1024, swz = sb ^ (((sb >> 9) & 1) << 5); R = (st >> 1) * 16 + swz / 64; C = (st & 1) * 32 + (swz % 64) / 2; }
struct Unit { int pm, pn; };
struct Gemm { const bf16_t* A; const bf16_t* Bt; int M, N, K; };
struct StaticOrder {
    int nM, nN, nwg, G, c;
    __device__ void init(int M, int N, int G_, int c_) { nM = M / BM; nN = N / BM; nwg = nM * nN; G = G_; c = c_; }
    __device__ bool next(int i, Unit& u) const {
        const long L = (long)i * G + c; if (L >= nwg) return false;
        int wgid = (int)L; { const int q = nwg / NXCD, r = nwg % NXCD, xcd = wgid % NXCD, off = wgid / NXCD; wgid = (xcd < r ? xcd * (q + 1) : r * (q + 1) + (xcd - r) * q) + off; }
        const int nig = WGM * nN, gid = wgid / nig, fm = gid * WGM, gsz = (nM - fm) < WGM ? (nM - fm) : WGM;
        u.pm = fm + ((wgid % nig) % gsz); u.pn = (wgid % nig) / gsz; return true;
    }
};
template <class Epi>
__device__ __forceinline__ void gemm_phase(PG8_LAS unsigned char* lds, const Gemm g, const StaticOrder& S, const Epi& E) {
    int tid = threadIdx.x; asm volatile("" : "+v"(tid));
    const int wid = __builtin_amdgcn_readfirstlane(tid >> 6), lane = tid & 63, wr = wid >> 2, wc = wid & 3, fr = lane & 15, fq = lane >> 4;
    const int K = g.K, nt = K / BK;
    unsigned voffA[2], voffB[2];
#pragma unroll
    for (int i = 0; i < 2; ++i) { int R, C; stage_rc(tid * 16 + i * 8192, R, C); const int Rb = Epi::PERM ? ((R & ~31) + perm32(R & 31)) : R;
        voffA[i] = (unsigned)(R * K + C) * 2u; voffB[i] = (unsigned)(Rb * K + C) * 2u; }
    const size_t kstep = (size_t)(BK * 2);
    const size_t hstep = (size_t)HALF * K * 2;
    const size_t tstep = 2 * hstep;
    const unsigned ldsw = (unsigned)wid * 1024u;
    const int aoff = lds_byte(wr * 64 + fr, fq * 8), boff = lds_byte(wc * 32 + fr, fq * 8);
#define PG8_SA(b, h) (((b) * 2 + (h)) * HTB)
#define PG8_SB(b, h) ((4 + (b) * 2 + (h)) * HTB)
#define PG8_STAGE2(bufoff, gbase, voff) do { _Pragma("unroll") for (int _i = 0; _i < 2; ++_i) \
        __builtin_amdgcn_global_load_lds((const unsigned*)((const char*)(gbase) + (voff)[_i]), (PG8_LAS unsigned*)(lds + (bufoff) + ldsw + _i * 8192), 16, 0, 0); } while (0)
#define PG8_LDA(dst, b, h) do { _Pragma("unroll") for (int m = 0; m < 4; ++m) _Pragma("unroll") for (int k = 0; k < 2; ++k) dst[m][k] = *(const PG8_LAS bf16x8*)(lds + PG8_SA(b, h) + aoff + m * 2048 + k * 1024); } while (0)
#define PG8_LDB(dst, b, h) do { _Pragma("unroll") for (int n = 0; n < 2; ++n) _Pragma("unroll") for (int k = 0; k < 2; ++k) dst[n][k] = *(const PG8_LAS bf16x8*)(lds + PG8_SB(b, h) + boff + n * 2048 + k * 1024); } while (0)
#define PG8_MMA(ai, bj, At, Bt) do { __builtin_amdgcn_s_setprio(1); _Pragma("unroll") for (int m = 0; m < 4; ++m) _Pragma("unroll") for (int n = 0; n < 2; ++n) _Pragma("unroll") for (int k = 0; k < 2; ++k) \
        acc[ai][bj][m][n] = __builtin_amdgcn_mfma_f32_16x16x32_bf16(Bt[n][k], At[m][k], acc[ai][bj][m][n], 0, 0, 0); __builtin_amdgcn_s_setprio(0); } while (0)
#define PG8_WAIT_V(n) asm volatile("s_waitcnt vmcnt(" #n ")" ::: "memory")
#define PG8_WAIT_L(n) asm volatile("s_waitcnt lgkmcnt(" #n ")" ::: "memory")
#define PG8_BAR __builtin_amdgcn_s_barrier()
#define PG8_SCHED __builtin_amdgcn_sched_barrier(0)
    Unit cur, nxt; int ui = 0;
    if (!S.next(0, cur)) return;
    f32x4 acc[2][2][4][2];
#pragma unroll
    for (int a = 0; a < 2; ++a)
#pragma unroll
        for (int b = 0; b < 2; ++b)
#pragma unroll
            for (int m = 0; m < 4; ++m)
#pragma unroll
                for (int n = 0; n < 2; ++n) acc[a][b][m][n] = (f32x4){0.f, 0.f, 0.f, 0.f};
    bf16x8 At[4][2], B0[2][2], B1[2][2];
    const char* cA = (const char*)g.A + (size_t)cur.pm * tstep; const char* cB = (const char*)g.Bt + (size_t)cur.pn * tstep;
    PG8_STAGE2(PG8_SB(0, 0), cB, voffB); PG8_STAGE2(PG8_SA(0, 0), cA, voffA); PG8_STAGE2(PG8_SB(0, 1), cB + hstep, voffB); PG8_STAGE2(PG8_SA(0, 1), cA + hstep, voffA);
    if (wr == 1) PG8_BAR;
    PG8_WAIT_V(4); PG8_BAR;
    PG8_STAGE2(PG8_SB(1, 0), cB + kstep, voffB); PG8_STAGE2(PG8_SA(1, 0), cA + kstep, voffA); PG8_STAGE2(PG8_SB(1, 1), cB + hstep + kstep, voffB);
    PG8_WAIT_V(6); PG8_BAR;
    for (;;) {
        const bool has_next = S.next(ui + 1, nxt);
        const char* nA = has_next ? (const char*)g.A + (size_t)nxt.pm * tstep : cA; const char* nB = has_next ? (const char*)g.Bt + (size_t)nxt.pn * tstep : cB;
        for (int t = 0; t < nt; t += 2) {
            const bool last = (t == nt - 2);
            const char* a1 = cA + (size_t)(t + 1) * kstep;
            const char* a2 = last ? nA : cA + (size_t)(t + 2) * kstep; const char* b2 = last ? nB : cB + (size_t)(t + 2) * kstep;
            const char* a3 = a2 + kstep; const char* b3 = b2 + kstep;
            PG8_LDB(B0, 0, 0); PG8_SCHED; PG8_LDA(At, 0, 0); PG8_STAGE2(PG8_SA(1, 1), a1 + hstep, voffA);
            PG8_WAIT_L(8); PG8_BAR; PG8_WAIT_L(0); PG8_MMA(0, 0, At, B0); PG8_BAR; PG8_SCHED;
            PG8_LDB(B1, 0, 1); PG8_STAGE2(PG8_SB(0, 0), b2, voffB);
            PG8_BAR; PG8_WAIT_L(0); PG8_MMA(0, 1, At, B1); PG8_BAR;
            PG8_LDA(At, 0, 1); PG8_STAGE2(PG8_SA(0, 0), a2, voffA);
            PG8_BAR; PG8_WAIT_L(0); PG8_MMA(1, 0, At, B0); PG8_BAR; PG8_SCHED;
            PG8_STAGE2(PG8_SB(0, 1), b2 + hstep, voffB);
            PG8_WAIT_V(6); PG8_BAR; PG8_MMA(1, 1, At, B1); PG8_BAR;
            PG8_LDB(B0, 1, 0); PG8_SCHED; PG8_LDA(At, 1, 0); PG8_STAGE2(PG8_SA(0, 1), a2 + hstep, voffA);
            PG8_WAIT_L(8); PG8_BAR; PG8_WAIT_L(0); PG8_MMA(0, 0, At, B0); PG8_BAR; PG8_SCHED;
            PG8_LDB(B1, 1, 1); PG8_STAGE2(PG8_SB(1, 0), b3, voffB);
            PG8_BAR; PG8_WAIT_L(0); PG8_MMA(0, 1, At, B1); PG8_BAR;
            PG8_LDA(At, 1, 1); PG8_STAGE2(PG8_SA(1, 0), a3, voffA);
            PG8_BAR; PG8_WAIT_L(0); PG8_MMA(1, 0, At, B0); PG8_BAR; PG8_SCHED;
            PG8_STAGE2(PG8_SB(1, 1), b3 + hstep, voffB);
            PG8_WAIT_V(6); PG8_BAR; PG8_MMA(1, 1, At, B1); PG8_BAR;
        }
        E(acc, cur, wr, wc, fr, fq);
        if (!has_next) break;
#pragma unroll
        for (int a = 0; a < 2; ++a)
#pragma unroll
            for (int b = 0; b < 2; ++b)
#pragma unroll
                for (int m = 0; m < 4; ++m)
#pragma unroll
                    for (int n = 0; n < 2; ++n) acc[a][b][m][n] = (f32x4){0.f, 0.f, 0.f, 0.f};
        cur = nxt; cA = nA; cB = nB; ++ui;
    }
    PG8_WAIT_V(0);
    if (wr == 0) PG8_BAR;
    PG8_BAR;
#undef PG8_SA
#undef PG8_SB
#undef PG8_STAGE2
#undef PG8_LDA
#undef PG8_LDB
#undef PG8_MMA
#undef PG8_WAIT_V
#undef PG8_WAIT_L
#undef PG8_BAR
#undef PG8_SCHED
}
}

typedef const f32x4 (&bigacc_t)[2][2][4][2];
#define BIG_LOOP                                                                                              \
    _Pragma("unroll") for (int ai = 0; ai < 2; ++ai) _Pragma("unroll") for (int m = 0; m < 4; ++m) {           \
        const int row = u.pm * 256 + ai * 128 + wr * 64 + m * 16 + fr;                                         \
        _Pragma("unroll") for (int bj = 0; bj < 2; ++bj) _Pragma("unroll") for (int n = 0; n < 2; ++n) {       \
            const int col = u.pn * 256 + bj * 128 + wc * 32 + n * 16 + 4 * fq;                                 \
            const float v0 = acc[ai][bj][m][n][0], v1 = acc[ai][bj][m][n][1], v2 = acc[ai][bj][m][n][2], v3 = acc[ai][bj][m][n][3];
#define BIG_END \
    }           \
    }

template <int R> __device__ __forceinline__ void epi_g1(const P& p, int L, int row, int col, float v0, float v1, float v2, float v3) {
    if (R == 0) st_bf4(p.UG + (size_t)row * DM + col, gelu_f(v0), gelu_f(v1), gelu_f(v2), gelu_f(v3));
    else if (R == 1) st_bf4(p.VG + (size_t)row * DM + (col - 1024), gelu_f(v0), gelu_f(v1), gelu_f(v2), gelu_f(v3));
    else if (R == 2) st_bf4(p.SZ + (size_t)row * DI + (col - 2048), silu_f(v0), silu_f(v1), silu_f(v2), silu_f(v3));
    else if (R == 3) st_bf4(p.XBC + (size_t)row * CD + (col - 4096), v0, v1, v2, v3);
    else if (R == 4) {
        const float4 b = *(const float4*)(p.b_gate + L * 2048 + (col - 7168));
        st_bf4(p.GCM + (size_t)row * DM + (col - 7168), sigmoid_f(v0 + b.x), sigmoid_f(v1 + b.y), sigmoid_f(v2 + b.z), sigmoid_f(v3 + b.w));
    } else if (R == 5) {
        const float4 b = *(const float4*)(p.b_gate + L * 2048 + 1024 + (col - 8192));
        st_bf4(p.GSSD + (size_t)row * DM + (col - 8192), sigmoid_f(v0 + b.x), sigmoid_f(v1 + b.y), sigmoid_f(v2 + b.z), sigmoid_f(v3 + b.w));
    } else {
        if (col < 9216 + 32) {
            const float4 b = *(const float4*)(p.dt_bias + L * NH + (col - 9216));
            *(float4*)(p.DT + (size_t)row * NH + (col - 9216)) = make_float4(softplus_f(v0 + b.x), softplus_f(v1 + b.y), softplus_f(v2 + b.z), softplus_f(v3 + b.w));
        }
    }
}
__device__ __forceinline__ void epi_res(const P& p, int L, int row, int col, float v0, float v1, float v2, float v3, const float* xr, int goff) {
    const float4 x = *(const float4*)(xr + col);
    const float4 g = *(const float4*)(p.mod + (size_t)modrow(row) * MODLD + L * 6144 + goff + col);
    *(float4*)(p.XB + (size_t)row * DM + col) = make_float4(ALPHA * x.x + g.x * v0, ALPHA * x.y + g.y * v1, ALPHA * x.z + g.z * v2, ALPHA * x.w + g.w * v3);
}
struct EpiBase { static constexpr bool PERM = false, AFTER_DRAIN = false; const P* pp; int L; };
struct EpiBaseP { static constexpr bool PERM = true, AFTER_DRAIN = false; const P* pp; int L; };
#define BIGP_LOOP                                                                                   \
    _Pragma("unroll") for (int ai = 0; ai < 2; ++ai) _Pragma("unroll") for (int m = 0; m < 4; ++m) { \
        const int row = u.pm * 256 + ai * 128 + wr * 64 + m * 16 + fr;                               \
        _Pragma("unroll") for (int bj = 0; bj < 2; ++bj) {                                           \
            const int col = u.pn * 256 + bj * 128 + wc * 32 + 8 * fq;                                \
            const f32x4 va = acc[ai][bj][m][0], vb = acc[ai][bj][m][1];
#define BIGP_END \
    }            \
    }
__device__ __forceinline__ void st_bf8(bf16_t* p, float a, float b, float c, float d, float e, float f, float g, float h) { *(u32x4*)p = (u32x4){pk2(a, b), pk2(c, d), pk2(e, f), pk2(g, h)}; }
template <int R> __device__ __forceinline__ void epi_g1p(const P& p, int L, int row, int col, const f32x4 va, const f32x4 vb) {
    if (R == 0) { const f32x2 a = gelu_pk2(va[0], va[1]), b = gelu_pk2(va[2], va[3]), c = gelu_pk2(vb[0], vb[1]), d = gelu_pk2(vb[2], vb[3]); st_bf8(p.UG + (size_t)row * DM + col, a.x, a.y, b.x, b.y, c.x, c.y, d.x, d.y); }
    else if (R == 1) { const f32x2 a = gelu_pk2(va[0], va[1]), b = gelu_pk2(va[2], va[3]), c = gelu_pk2(vb[0], vb[1]), d = gelu_pk2(vb[2], vb[3]); st_bf8(p.VG + (size_t)row * DM + (col - 1024), a.x, a.y, b.x, b.y, c.x, c.y, d.x, d.y); }
    else if (R == 2) st_bf8(p.SZ + (size_t)row * DI + (col - 2048), silu_f(va[0]), silu_f(va[1]), silu_f(va[2]), silu_f(va[3]), silu_f(vb[0]), silu_f(vb[1]), silu_f(vb[2]), silu_f(vb[3]));
    else if (R == 3) st_bf8(p.XBC + (size_t)row * CD + (col - 4096), va[0], va[1], va[2], va[3], vb[0], vb[1], vb[2], vb[3]);
    else if (R == 4 || R == 5) {
        const int gc = col - (R == 4 ? 7168 : 8192);
        const float* bg = p.b_gate + L * 2048 + (R == 4 ? 0 : 1024) + gc;
        const float4 b0 = *(const float4*)bg, b1 = *(const float4*)(bg + 4);
        st_bf8((R == 4 ? p.GCM : p.GSSD) + (size_t)row * DM + gc, sigmoid_f(va[0] + b0.x), sigmoid_f(va[1] + b0.y), sigmoid_f(va[2] + b0.z), sigmoid_f(va[3] + b0.w),
               sigmoid_f(vb[0] + b1.x), sigmoid_f(vb[1] + b1.y), sigmoid_f(vb[2] + b1.z), sigmoid_f(vb[3] + b1.w));
    } else {
        if (col < 9216 + 32) {
            const float* db = p.dt_bias + L * NH + (col - 9216);
            const float4 b0 = *(const float4*)db, b1 = *(const float4*)(db + 4);
            float* d = p.DT + (size_t)row * NH + (col - 9216);
            *(float4*)d = make_float4(softplus_f(va[0] + b0.x), softplus_f(va[1] + b0.y), softplus_f(va[2] + b0.z), softplus_f(va[3] + b0.w));
            *(float4*)(d + 4) = make_float4(softplus_f(vb[0] + b1.x), softplus_f(vb[1] + b1.y), softplus_f(vb[2] + b1.z), softplus_f(vb[3] + b1.w));
        }
    }
}
struct EpiG1 : EpiBaseP {
    template <int R> __device__ __forceinline__ void run(bigacc_t acc, const pg8::Unit& u, int wr, int wc, int fr, int fq) const {
        BIGP_LOOP epi_g1p<R>(*pp, L, row, col, va, vb); BIGP_END
    }
    __device__ __forceinline__ void operator()(bigacc_t acc, const pg8::Unit& u, int wr, int wc, int fr, int fq) const {
        const int pn = u.pn;
        if (pn < 4) run<0>(acc, u, wr, wc, fr, fq); else if (pn < 8) run<1>(acc, u, wr, wc, fr, fq); else if (pn < 16) run<2>(acc, u, wr, wc, fr, fq);
        else if (pn < 28) run<3>(acc, u, wr, wc, fr, fq); else if (pn < 32) run<4>(acc, u, wr, wc, fr, fq); else if (pn < 36) run<5>(acc, u, wr, wc, fr, fq);
        else run<6>(acc, u, wr, wc, fr, fq);
    }
};
struct EpiG2a : EpiBaseP {
    __device__ __forceinline__ void operator()(bigacc_t acc, const pg8::Unit& u, int wr, int wc, int fr, int fq) const {
        const P& p = *pp;
        BIGP_LOOP
            const u32x4 gu = *(const u32x4*)(p.GCM + (size_t)row * DM + col);
            st_bf8(p.MRG + (size_t)row * DM + col, va[0] * lo16(gu[0]), va[1] * hi16(gu[0]), va[2] * lo16(gu[1]), va[3] * hi16(gu[1]),
                   vb[0] * lo16(gu[2]), vb[1] * hi16(gu[2]), vb[2] * lo16(gu[3]), vb[3] * hi16(gu[3]));
        BIGP_END
    }
};
struct EpiG2b : EpiBaseP {
    __device__ __forceinline__ void operator()(bigacc_t acc, const pg8::Unit& u, int wr, int wc, int fr, int fq) const {
        const P& p = *pp;
#pragma unroll
        for (int ai = 0; ai < 2; ++ai)
#pragma unroll
            for (int m = 0; m < 4; ++m) {
                const int row = u.pm * 256 + ai * 128 + wr * 64 + m * 16 + fr;
                float s = 0.f;
#pragma unroll
                for (int j = 0; j < 8; ++j) { const float4 x = *(const float4*)(p.SSQ + (size_t)row * NH + 4 * j); s += x.x + x.y + x.z + x.w; }
                const float rstd = rsqrtf(s * (1.f / 2048.f) + EPS);
#pragma unroll
                for (int bj = 0; bj < 2; ++bj) {
                    const int col = u.pn * 256 + bj * 128 + wc * 32 + 8 * fq;
                    const f32x4 va = acc[ai][bj][m][0], vb = acc[ai][bj][m][1];
                    const u32x4 gu = *(const u32x4*)(p.GSSD + (size_t)row * DM + col);
                    const u32x4 pr = *(const u32x4*)(p.MRG + (size_t)row * DM + col);
                    st_bf8(p.MRG + (size_t)row * DM + col, lo16(pr[0]) + va[0] * rstd * lo16(gu[0]), hi16(pr[0]) + va[1] * rstd * hi16(gu[0]), lo16(pr[1]) + va[2] * rstd * lo16(gu[1]),
                           hi16(pr[1]) + va[3] * rstd * hi16(gu[1]), lo16(pr[2]) + vb[0] * rstd * lo16(gu[2]), hi16(pr[2]) + vb[1] * rstd * hi16(gu[2]),
                           lo16(pr[3]) + vb[2] * rstd * lo16(gu[3]), hi16(pr[3]) + vb[3] * rstd * hi16(gu[3]));
                }
            }
    }
};
struct EpiG3 : EpiBase {
    __device__ __forceinline__ void operator()(bigacc_t acc, const pg8::Unit& u, int wr, int wc, int fr, int fq) const {
        const P& p = *pp;
        BIG_LOOP
            const float* xr = (L == 0) ? p.x_prompt + (size_t)row * DM : p.XB + (size_t)row * DM;
            epi_res(p, L, row, col, v0, v1, v2, v3, xr, 2048);
        BIG_END
    }
};
struct EpiG5 : EpiBase {
    __device__ __forceinline__ void operator()(bigacc_t acc, const pg8::Unit& u, int wr, int wc, int fr, int fq) const {
        const P& p = *pp;
        BIG_LOOP epi_res(p, L, row, col, v0, v1, v2, v3, p.XB + (size_t)row * DM, 5120); BIG_END
    }
};
struct EpiG4 : EpiBase {
    __device__ __forceinline__ void operator()(bigacc_t acc, const pg8::Unit& u, int wr, int wc, int fr, int fq) const {
        const P& p = *pp;
#pragma unroll
        for (int ai = 0; ai < 2; ++ai)
#pragma unroll
            for (int m = 0; m < 4; ++m) {
                const int row = u.pm * 256 + ai * 128 + wr * 64 + m * 16 + fr;
#pragma unroll
                for (int bj = 0; bj < 2; ++bj) {
                    const int fc = 16 * (u.pn * 8 + bj * 4 + wc) + 4 * fq;
                    const f32x4 gt = acc[ai][bj][m][0], up = acc[ai][bj][m][1];
                    st_bf4(p.GU + (size_t)row * DFF + fc, silu_f(gt[0]) * up[0], silu_f(gt[1]) * up[1], silu_f(gt[2]) * up[2], silu_f(gt[3]) * up[3]);
                }
            }
    }
};
template <class Epi> __device__ __forceinline__ void big_gemm(const P& p, int L, const bf16_t* A, const bf16_t* Bt, int N, int K, unsigned char* smem_raw) {
    pg8::Gemm g; g.A = A; g.Bt = Bt; g.M = MPR; g.N = N; g.K = K;
    int cwg = blockIdx.x; asm volatile("" : "+s"(cwg));
    pg8::StaticOrder S; S.init(MPR, N, gridDim.x, cwg);
    Epi E; E.pp = &p; E.L = L;
    pg8::gemm_phase(( PG8_LAS unsigned char*)smem_raw, g, S, E);
}

#define SMALL_G1(R) EPI_BEGIN(acc, m0, n0) epi_g1<R>(p, L, row, col, v0, v1, v2, v3); EPI_END
__device__ void phase_g1(const P& p, int L, bf16_t* smem, unsigned char* smem_raw) {
    const bf16_t* W = p.Wt_in + (size_t)L * NIN * DM;
    big_gemm<EpiG1>(p, L, p.H, W, NIN, DM, smem_raw);
    for (int t = (bidx() + vgrid() - 128) % vgrid(); t < 74; t += vgrid()) {
        const int nt = t < 73 ? t : 72, m0 = MPR, n0 = nt * 128;
        f32x16 acc[2][2]; ZERO_ACC(acc);
        gemm_mainloop(acc, p.H, DM, W, DM, DM, m0, n0, smem);
        if (nt < 8) { SMALL_G1(0) } else if (nt < 16) { SMALL_G1(1) } else if (nt < 32) { SMALL_G1(2) } else if (nt < 56) { SMALL_G1(3) }
        else if (nt < 64) { SMALL_G1(4) } else if (nt < 72) { SMALL_G1(5) } else { SMALL_G1(6) }
    }
}

__device__ __forceinline__ void unpack8(const uint4 u, float (&f)[8]) {
    f[0] = lo16(u.x); f[1] = hi16(u.x); f[2] = lo16(u.y); f[3] = hi16(u.y); f[4] = lo16(u.z); f[5] = hi16(u.z); f[6] = lo16(u.w); f[7] = hi16(u.w);
}
__device__ void phase_c(const P& p, int L) {
    const int nth = vgrid() * THREADS, gt = bidx() * THREADS + tidx();
    const float* cw = p.conv_w + (size_t)L * 4 * CD;
    const float* cb = p.conv_b + (size_t)L * CD;
    for (int it = gt; it < (MPR / 16) * 384; it += nth) {
        const int rb = it / 384, j0 = (it % 384) * 8;
        const int mb = rb * 16, t0 = mb & (SEQ - 1), b = mb >> 11;
        float w[4][8], bias[8], h0[8], h1[8], h2[8];
#pragma unroll
        for (int k = 0; k < 4; ++k) { const float4 a = *(const float4*)(cw + k * CD + j0), c = *(const float4*)(cw + k * CD + j0 + 4);
            w[k][0] = a.x; w[k][1] = a.y; w[k][2] = a.z; w[k][3] = a.w; w[k][4] = c.x; w[k][5] = c.y; w[k][6] = c.z; w[k][7] = c.w; }
        { const float4 a = *(const float4*)(cb + j0), c = *(const float4*)(cb + j0 + 4); bias[0] = a.x; bias[1] = a.y; bias[2] = a.z; bias[3] = a.w; bias[4] = c.x; bias[5] = c.y; bias[6] = c.z; bias[7] = c.w; }
        if (t0 == 0) {
#pragma unroll
            for (int e = 0; e < 8; ++e) { h0[e] = 0.f; h1[e] = 0.f; h2[e] = 0.f; }
        } else {
            unpack8(*(const uint4*)(p.XBC + (size_t)(mb - 3) * CD + j0), h0);
            unpack8(*(const uint4*)(p.XBC + (size_t)(mb - 2) * CD + j0), h1);
            unpack8(*(const uint4*)(p.XBC + (size_t)(mb - 1) * CD + j0), h2);
        }
        uint4 xr16[16];
#pragma unroll
        for (int r = 0; r < 16; ++r) xr16[r] = *(const uint4*)(p.XBC + (size_t)(mb + r) * CD + j0);
#pragma unroll
        for (int r = 0; r < 16; ++r) {
            const int m = mb + r;
            float x[8], o[8];
            unpack8(xr16[r], x);
#pragma unroll
            for (int e = 0; e < 8; ++e) { o[e] = silu_f(bias[e] + w[0][e] * h0[e] + w[1][e] * h1[e] + w[2][e] * h2[e] + w[3][e] * x[e]); h0[e] = h1[e]; h1[e] = h2[e]; h2[e] = x[e]; }
            *(uint4*)(p.XC + (size_t)m * CD + j0) = make_uint4(pk2(o[0], o[1]), pk2(o[2], o[3]), pk2(o[4], o[5]), pk2(o[6], o[7]));
            const int tt = t0 + r;
            if (tt >= SEQ - 3) {
                float* d = p.out + O3 + ((size_t)(L * NB + b) * 3 + (tt - (SEQ - 3))) * CD + j0;
                *(float4*)d = make_float4(x[0], x[1], x[2], x[3]); *(float4*)(d + 4) = make_float4(x[4], x[5], x[6], x[7]);
            }
        }
    }
    for (int it = gt; it < NS * 384; it += nth) {
        const int b = it / 384, j0 = (it % 384) * 8, m = MPR + b;
        const float* sc = p.state_conv + ((size_t)(L * NS + b) * 3) * CD + j0;
        float* oc = p.out + O5 + ((size_t)(L * NS + b) * 3) * CD + j0;
        float x[8], o[8];
        unpack8(*(const uint4*)(p.XBC + (size_t)m * CD + j0), x);
#pragma unroll
        for (int e = 0; e < 8; ++e) {
            const float a0 = sc[e], a1 = sc[CD + e], a2 = sc[2 * CD + e];
            o[e] = silu_f(cb[j0 + e] + cw[j0 + e] * a0 + cw[CD + j0 + e] * a1 + cw[2 * CD + j0 + e] * a2 + cw[3 * CD + j0 + e] * x[e]);
            oc[e] = a1; oc[CD + e] = a2; oc[2 * CD + e] = x[e];
        }
        *(uint4*)(p.XC + (size_t)m * CD + j0) = make_uint4(pk2(o[0], o[1]), pk2(o[2], o[3]), pk2(o[4], o[5]), pk2(o[6], o[7]));
    }
    const int lane = tidx() & 63, gw = gt >> 6, nw = nth >> 6;
    for (int m0 = 4 * gw; m0 < MPR; m0 += 4 * nw) {
        float vv[4][16], s4[4], q4[4], mu4[4];
#pragma unroll
        for (int r = 0; r < 4; ++r) {
            const uint4 ua = *(const uint4*)(p.VG + (size_t)(m0 + r) * DM + lane * 8), ub = *(const uint4*)(p.VG + (size_t)(m0 + r) * DM + 512 + lane * 8);
            unpack8(ua, *(float(*)[8])&vv[r][0]); unpack8(ub, *(float(*)[8])&vv[r][8]);
        }
#pragma unroll
        for (int r = 0; r < 4; ++r) { s4[r] = 0.f;
#pragma unroll
            for (int e = 0; e < 16; ++e) s4[r] += vv[r][e]; }
#pragma unroll
        for (int o = 32; o > 0; o >>= 1) {
#pragma unroll
            for (int r = 0; r < 4; ++r) s4[r] += __shfl_xor(s4[r], o); }
#pragma unroll
        for (int r = 0; r < 4; ++r) { mu4[r] = s4[r] * (1.f / 1024.f); q4[r] = 0.f;
#pragma unroll
            for (int e = 0; e < 16; ++e) { const float d = vv[r][e] - mu4[r]; q4[r] += d * d; } }
#pragma unroll
        for (int o = 32; o > 0; o >>= 1) {
#pragma unroll
            for (int r = 0; r < 4; ++r) q4[r] += __shfl_xor(q4[r], o); }
        if (lane == 0) {
            *(float4*)(p.VST + 2 * m0) = make_float4(mu4[0], rsqrtf(q4[0] * (1.f / 1024.f) + EPS), mu4[1], rsqrtf(q4[1] * (1.f / 1024.f) + EPS));
            *(float4*)(p.VST + 2 * m0 + 4) = make_float4(mu4[2], rsqrtf(q4[2] * (1.f / 1024.f) + EPS), mu4[3], rsqrtf(q4[3] * (1.f / 1024.f) + EPS));
        }
    }
    for (int m = MPR + gw; m < MT; m += nw) {
        float v[16];
        unpack8(*(const uint4*)(p.VG + (size_t)m * DM + lane * 8), *(float(*)[8])&v[0]);
        unpack8(*(const uint4*)(p.VG + (size_t)m * DM + 512 + lane * 8), *(float(*)[8])&v[8]);
        float s = 0.f;
#pragma unroll
        for (int e = 0; e < 16; ++e) s += v[e];
        const float mu = wave_sum(s) * (1.f / 1024.f);
        float q = 0.f;
#pragma unroll
        for (int e = 0; e < 16; ++e) { const float d = v[e] - mu; q += d * d; }
        const float rstd = rsqrtf(wave_sum(q) * (1.f / 1024.f) + EPS);
        if (lane == 0) { p.VST[2 * m] = mu; p.VST[2 * m + 1] = rstd; }
        if (m >= MPR) {
            const int b = m - MPR;
#pragma unroll
            for (int hh = 0; hh < 2; ++hh) {
                const int c0 = hh * 512 + lane * 8, g = c0 >> 7;
                const float w00 = p.w_spatial[((size_t)(L * 8 + g) * 128) * 128], b0 = p.b_spatial[(L * 8 + g) * 128];
                float ug[8], o[8];
                unpack8(*(const uint4*)(p.UG + (size_t)m * DM + c0), ug);
#pragma unroll
                for (int e = 0; e < 8; ++e) {
                    const float ln = (v[hh * 8 + e] - mu) * rstd * p.ln_v_g[L * DM + c0 + e] + p.ln_v_b[L * DM + c0 + e];
                    p.out[O6 + (size_t)(L * NS + b) * DM + c0 + e] = ln;
                    o[e] = ug[e] * (w00 * ln + b0);
                }
                *(uint4*)(p.OCM + (size_t)m * DM + c0) = make_uint4(pk2(o[0], o[1]), pk2(o[2], o[3]), pk2(o[4], o[5]), pk2(o[6], o[7]));
            }
        }
    }
}

__device__ __forceinline__ void scan128(float v, float* out, float* tmp, int tid) {
    const int lane = tid & 63;
#pragma unroll
    for (int o = 1; o < 64; o <<= 1) { const float t = __shfl_up(v, o); if (lane >= o) v += t; }
    if (tid == 63) *tmp = v;
    __syncthreads();
    if (tid >= 64 && tid < 128) v += *tmp;
    if (tid < 128) out[tid] = v;
}

__device__ void states_task(const P& p, int L, int task, bf16_t* smem) {
    const int tid = tidx(), lane = tid & 63, wave = tid >> 6;
    const int g = task & 3, bc = task >> 2, m0 = bc * 128;
    bf16_t* BT = smem;
    bf16_t* XT = smem + 128 * TS;
    float* fa = (float*)(smem + 192 * TS);
    __syncthreads();
    {
        const int l = tid >> 1, half = tid & 1;
        const bf16_t* src = p.XC + (size_t)(m0 + l) * CD + DI + 128 * g + 64 * half;
#pragma unroll
        for (int j = 0; j < 8; ++j) {
            const uint4 u = *(const uint4*)(src + 8 * j);
            const unsigned w[4] = {u.x, u.y, u.z, u.w};
#pragma unroll
            for (int e = 0; e < 4; ++e) { BT[(64 * half + 8 * j + 2 * e) * TS + l] = (bf16_t)(w[e] & 0xffffu); BT[(64 * half + 8 * j + 2 * e + 1) * TS + l] = (bf16_t)(w[e] >> 16); }
        }
    }
    for (int e8 = 0; e8 < 8; ++e8) {
        const int h = 8 * g + e8;
        const float a = -__expf(p.a_log[L * NH + h]);
        __syncthreads();
        const float dtv = (tid < 128) ? p.DT[(size_t)(m0 + tid) * NH + h] : 0.f;
        scan128(dtv * a, fa, fa + 256, tid);
        __syncthreads();
        if (tid < 128) fa[128 + tid] = dtv * __expf(fa[127] - fa[tid]);
        __syncthreads();
        {
            const int l = tid >> 1, half = tid & 1;
            const float wl = fa[128 + l];
            const bf16_t* src = p.XC + (size_t)(m0 + l) * CD + 64 * h + 32 * half;
#pragma unroll
            for (int j = 0; j < 4; ++j) {
                float x[8]; unpack8(*(const uint4*)(src + 8 * j), x);
#pragma unroll
                for (int e = 0; e < 8; ++e) XT[(32 * half + 8 * j + e) * TS + l] = f2bf(x[e] * wl);
            }
        }
        __syncthreads();
        f32x16 acc[2];
#pragma unroll
        for (int i = 0; i < 2; ++i)
#pragma unroll
            for (int r = 0; r < 16; ++r) acc[i][r] = 0.f;
#pragma unroll
        for (int ks = 0; ks < 8; ++ks) {
            const bf16x8 bfr = *(const bf16x8*)(BT + (32 * wave + (lane & 31)) * TS + ks * 16 + (lane >> 5) * 8);
#pragma unroll
            for (int mi = 0; mi < 2; ++mi) {
                const bf16x8 af = *(const bf16x8*)(XT + (32 * mi + (lane & 31)) * TS + ks * 16 + (lane >> 5) * 8);
                acc[mi] = __builtin_amdgcn_mfma_f32_32x32x16_bf16(bfr, af, acc[mi], 0, 0, 0);
            }
        }
        float* dst = p.ST + ((size_t)(bc * NH + h) * 64) * 128;
#pragma unroll
        for (int mi = 0; mi < 2; ++mi)
#pragma unroll
            for (int q = 0; q < 4; ++q)
                *(float4*)(dst + (size_t)(32 * mi + (lane & 31)) * 128 + 32 * wave + 8 * q + 4 * (lane >> 5)) =
                    make_float4(acc[mi][4 * q], acc[mi][4 * q + 1], acc[mi][4 * q + 2], acc[mi][4 * q + 3]);
        if (tid == 0) p.CDEC[bc * NH + h] = __expf(fa[127]);
    }
}

__device__ void mix_task(const P& p, int L, int task, bf16_t* smem) {
    const int tid = tidx(), lane = tid & 63, wave = tid >> 6, wm = wave >> 1, wn = wave & 1;
    const int g = task & 7, ck = task >> 3, m0 = ck * 128;
    bf16_t* WM = smem;
    bf16_t* VT = smem + 128 * TS;
    __syncthreads();
    {
        const int i = tid >> 1, half = tid & 1;
        const float* src = p.w_spatial + ((size_t)(L * 8 + g) * 128 + i) * 128 + 64 * half;
#pragma unroll
        for (int j = 0; j < 16; ++j) {
            const float4 w = *(const float4*)(src + 4 * j);
            const int jj = 64 * half + 4 * j;
            st_bf4(WM + i * TS + jj, jj <= i ? w.x : 0.f, jj + 1 <= i ? w.y : 0.f, jj + 2 <= i ? w.z : 0.f, jj + 3 <= i ? w.w : 0.f);
        }
        const int m = m0 + i;
        const float mu = p.VST[2 * m], rstd = p.VST[2 * m + 1];
        const bf16_t* vs = p.VG + (size_t)m * DM + 128 * g + 64 * half;
        const float* gg = p.ln_v_g + L * DM + 128 * g + 64 * half;
        const float* bb = p.ln_v_b + L * DM + 128 * g + 64 * half;
#pragma unroll
        for (int j = 0; j < 8; ++j) {
            float x[8]; unpack8(*(const uint4*)(vs + 8 * j), x);
#pragma unroll
            for (int e = 0; e < 8; ++e) VT[(64 * half + 8 * j + e) * TS + i] = f2bf((x[e] - mu) * rstd * gg[8 * j + e] + bb[8 * j + e]);
        }
    }
    __syncthreads();
    f32x16 acc[2][2]; ZERO_ACC(acc);
#pragma unroll
    for (int ks = 0; ks < 8; ++ks) {
        bf16x8 af[2], bfr[2];
#pragma unroll
        for (int i = 0; i < 2; ++i) {
            af[i] = *(const bf16x8*)(WM + (wm * 64 + i * 32 + (lane & 31)) * TS + ks * 16 + (lane >> 5) * 8);
            bfr[i] = *(const bf16x8*)(VT + (wn * 64 + i * 32 + (lane & 31)) * TS + ks * 16 + (lane >> 5) * 8);
        }
#pragma unroll
        for (int mi = 0; mi < 2; ++mi)
#pragma unroll
            for (int ni = 0; ni < 2; ++ni) acc[mi][ni] = __builtin_amdgcn_mfma_f32_32x32x16_bf16(bfr[ni], af[mi], acc[mi][ni], 0, 0, 0);
    }
    const float* bs = p.b_spatial + (L * 8 + g) * 128;
    EPI_BEGIN(acc, 0, 0)
        const float bi = bs[row];
        const uint2 u = *(const uint2*)(p.UG + (size_t)(m0 + row) * DM + 128 * g + col);
        st_bf4(p.OCM + (size_t)(m0 + row) * DM + 128 * g + col, lo16(u.x) * (v0 + bi), hi16(u.x) * (v1 + bi), lo16(u.y) * (v2 + bi), hi16(u.y) * (v3 + bi));
    EPI_END
}

__device__ void sample_ssd_task(const P& p, int L, int task, float* red) {
    const int tid = tidx();
    const int h0 = (task & 15) * 2, b = task >> 4, m = MPR + b, g = h0 >> 3;
    const int n4 = (tid & 31) * 4, pb = tid >> 5;
    const bf16_t* xr = p.XC + (size_t)m * CD;
    const uint2 bu = *(const uint2*)(xr + DI + 128 * g + n4), cu = *(const uint2*)(xr + DI + 512 + 128 * g + n4);
    const float B0 = lo16(bu.x), B1 = hi16(bu.x), B2 = lo16(bu.y), B3 = hi16(bu.y);
    const float C0 = lo16(cu.x), C1 = hi16(cu.x), C2 = lo16(cu.y), C3 = hi16(cu.y);
    float dtv[2], dec[2], dsk[2];
#pragma unroll
    for (int hh = 0; hh < 2; ++hh) { dtv[hh] = p.DT[(size_t)m * NH + h0 + hh]; dec[hh] = __expf(-dtv[hh] * __expf(p.a_log[L * NH + h0 + hh])); dsk[hh] = p.d_skip[L * NH + h0 + hh]; }
    const size_t sbase = ((size_t)((L * NS + b) * NH + h0) * 64) * 128;
    float4 st[16];
#pragma unroll
    for (int i = 0; i < 16; ++i) { const f32x4 t = __builtin_nontemporal_load((const f32x4*)(p.state_ssd + sbase + (size_t)(pb + 8 * i) * 128 + n4)); st[i] = make_float4(t[0], t[1], t[2], t[3]); }
    __syncthreads();
#pragma unroll
    for (int i = 0; i < 16; ++i) {
        const int hh = i >> 3, pi = pb + 8 * (i & 7);
        const float xv = bf2f(xr[64 * (h0 + hh) + pi]), xd = xv * dtv[hh];
        const float4 hn = make_float4(st[i].x * dec[hh] + xd * B0, st[i].y * dec[hh] + xd * B1, st[i].z * dec[hh] + xd * B2, st[i].w * dec[hh] + xd * B3);
        __builtin_nontemporal_store((f32x4){hn.x, hn.y, hn.z, hn.w}, (f32x4*)(p.out + O4 + sbase + (size_t)(pb + 8 * i) * 128 + n4));
        float part = hn.x * C0 + hn.y * C1 + hn.z * C2 + hn.w * C3;
#pragma unroll
        for (int o = 16; o > 0; o >>= 1) part += __shfl_xor(part, o);
        if ((tid & 31) == 0) {
            const float y = part + dsk[hh] * xv;
            const float yg = y * bf2f(p.SZ[(size_t)m * DI + 64 * (h0 + hh) + pi]);
            p.YG[(size_t)m * DI + 64 * (h0 + hh) + pi] = f2bf(yg);
            red[64 * hh + pi] = yg * yg;
        }
    }
    __syncthreads();
    if (tid < 128) { const float s = wave_sum(red[tid]); if ((tid & 63) == 0) p.SSQ[(size_t)m * NH + h0 + (tid >> 6)] = s; }
}

constexpr int S1_STATES = NB * NCK * 4, S1_MIX = 128 * 8, S1_SAMPLE = NS * NH / 2;
__device__ void phase_s1(const P& p, int L, bf16_t* smem) {
    for (int t = bidx(); t < S1_STATES + S1_MIX + S1_SAMPLE; t += vgrid()) {
        if (t < S1_STATES) states_task(p, L, t, smem);
        else if (t < S1_STATES + S1_MIX) mix_task(p, L, t - S1_STATES, smem);
        else sample_ssd_task(p, L, t - S1_STATES - S1_MIX, (float*)smem);
    }
}

__device__ void phase_s2(const P& p, int L) {
    const int nth = vgrid() * THREADS;
    for (int it = bidx() * THREADS + tidx(); it < NB * NH * 64 * 32; it += nth) {
        const int n4 = (it & 31) * 4, pi = (it >> 5) & 63, h = (it >> 11) & 31, b = it >> 16;
        float4 hc = make_float4(0.f, 0.f, 0.f, 0.f);
#pragma unroll
        for (int c = 0; c < NCK; ++c) {
            const int bc = b * NCK + c;
            const size_t o = ((size_t)(bc * NH + h) * 64 + pi) * 128 + n4;
            const float4 s = *(const float4*)(p.ST + o);
            const float d = p.CDEC[bc * NH + h];
            st_bf4(p.ST16 + o, hc.x, hc.y, hc.z, hc.w);
            hc = make_float4(hc.x * d + s.x, hc.y * d + s.y, hc.z * d + s.z, hc.w * d + s.w);
        }
        *(float4*)(p.out + O2 + ((size_t)((L * NB + b) * NH + h) * 64 + pi) * 128 + n4) = hc;
    }
}

__device__ void ssdout_task(const P& p, int L, int task, bf16_t* smem) {
    const int tid = tidx(), lane = tid & 63, w = __builtin_amdgcn_readfirstlane(tid >> 6), hl = lane >> 5;
    const int g = task & 3, bc = task >> 2, m0 = bc * 128;
    bf16_t* R1 = smem;
    bf16_t* R2 = smem + 128 * TS;
    float* fa = (float*)(smem + 256 * TS);
    const int sx = tid >> 1, xh = tid & 1;
    const int pi = tid >> 2, nq = (tid & 3) * 32;
    u32x4 xr[4], hr[4]; float dtn;
#define S3_PREFETCH(hh)                                                                                          \
    {                                                                                                            \
        const bf16_t* _xs = p.XC + (size_t)(m0 + sx) * CD + 64 * (hh) + 32 * xh;                                 \
        _Pragma("unroll") for (int j = 0; j < 4; ++j) xr[j] = *(const u32x4*)(_xs + 8 * j);                      \
        const bf16_t* _hs = p.ST16 + ((size_t)(bc * NH + (hh)) * 64 + pi) * 128 + nq;                            \
        _Pragma("unroll") for (int j = 0; j < 4; ++j) hr[j] = *(const u32x4*)(_hs + 8 * j);                      \
        dtn = (tid < 128) ? p.DT[(size_t)(m0 + tid) * NH + (hh)] : 0.f;                                          \
    }
    __syncthreads();
    {
        const int l = tid >> 1, half = tid & 1;
        const bf16_t* src = p.XC + (size_t)(m0 + l) * CD + DI + 128 * g + 64 * half;
#pragma unroll
        for (int j = 0; j < 8; ++j) {
            *(u32x4*)(R1 + l * TS + 64 * half + 8 * j) = *(const u32x4*)(src + 512 + 8 * j);
            *(u32x4*)(R2 + l * TS + 64 * half + 8 * j) = *(const u32x4*)(src + 8 * j);
        }
    }
    __syncthreads();
    const int frag = (lane & 31) * TS + hl * 8;
    f32x16 cb[4];
#pragma unroll
    for (int i = 0; i < 4; ++i)
#pragma unroll
        for (int r = 0; r < 16; ++r) cb[i][r] = 0.f;
#pragma unroll 2
    for (int ks = 0; ks < 8; ++ks) {
        const bf16x8 cf = *(const bf16x8*)(R1 + 32 * w * TS + frag + ks * 16);
#pragma unroll
        for (int sj = 0; sj < 4; ++sj)
            if (sj <= w) {
                const bf16x8 bf = *(const bf16x8*)(R2 + 32 * sj * TS + frag + ks * 16);
                cb[sj] = __builtin_amdgcn_mfma_f32_32x32x16_bf16(bf, cf, cb[sj], 0, 0, 0);
            }
    }
    const int l = 32 * w + (lane & 31);
    float* Y = (float*)R2;
    for (int e8 = 0; e8 < 8; ++e8) {
        const int h = 8 * g + e8;
        const float a = -__expf(p.a_log[L * NH + h]), dsk = p.d_skip[L * NH + h];
        S3_PREFETCH(h)
        const float dtv = dtn;
        __syncthreads();
        if (tid < 128) fa[128 + tid] = dtv;
        scan128(dtv * a, fa, fa + 256, tid);
        {
            const float dts = fa[128 + sx];
#pragma unroll
            for (int j = 0; j < 4; ++j) {
                float x[8];
                x[0] = lo16(xr[j][0]); x[1] = hi16(xr[j][0]); x[2] = lo16(xr[j][1]); x[3] = hi16(xr[j][1]);
                x[4] = lo16(xr[j][2]); x[5] = hi16(xr[j][2]); x[6] = lo16(xr[j][3]); x[7] = hi16(xr[j][3]);
#pragma unroll
                for (int e = 0; e < 8; ++e) R2[(32 * xh + 8 * j + e) * TS + sx] = f2bf(x[e] * dts);
            }
#pragma unroll
            for (int j = 0; j < 4; ++j) *(u32x4*)(R2 + (64 + pi) * TS + nq + 8 * j) = hr[j];
        }
        unsigned warm = 0u;
        u32x4 wx[2], wh[2];
        if (e8 < 7) {
            const bf16_t* nx = p.XC + (size_t)(m0 + sx) * CD + 64 * (h + 1) + 32 * xh;
            const bf16_t* nh = p.ST16 + ((size_t)(bc * NH + h + 1) * 64 + pi) * 128 + nq;
            wx[0] = *(const u32x4*)nx; wx[1] = *(const u32x4*)(nx + 16); wh[0] = *(const u32x4*)nh; wh[1] = *(const u32x4*)(nh + 16);
        }
        u32x4 zr[4];
        {
            const bf16_t* zs = p.SZ + (size_t)(m0 + sx) * DI + 64 * h + 32 * xh;
#pragma unroll
            for (int j = 0; j < 4; ++j) zr[j] = *(const u32x4*)(zs + 8 * j);
        }
        __syncthreads();
        const float al = fa[l];
        f32x16 acc[2];
#pragma unroll
        for (int i = 0; i < 2; ++i)
#pragma unroll
            for (int r = 0; r < 16; ++r) acc[i][r] = 0.f;
#pragma unroll 2
        for (int ks = 0; ks < 8; ++ks) {
            const bf16x8 cf = *(const bf16x8*)(R1 + 32 * w * TS + frag + ks * 16);
#pragma unroll
            for (int ni = 0; ni < 2; ++ni) {
                const bf16x8 hf = *(const bf16x8*)(R2 + (64 + 32 * ni) * TS + frag + ks * 16);
                acc[ni] = __builtin_amdgcn_mfma_f32_32x32x16_bf16(hf, cf, acc[ni], 0, 0, 0);
            }
        }
        const float el = __expf(al);
#pragma unroll
        for (int i = 0; i < 2; ++i)
#pragma unroll
            for (int r = 0; r < 16; ++r) acc[i][r] *= el;
        int fo = 4 * hl, lrel = (lane & 31) - 4 * hl;
        asm volatile("" : "+v"(fo), "+v"(lrel));
        const float* fab = fa + fo;
#pragma unroll
        for (int sj = 0; sj < 4; ++sj)
            if (sj <= w) {
#pragma unroll
                for (int s2 = 0; s2 < 2; ++s2) {
                    const float4 a0 = *(const float4*)(fab + 32 * sj + 16 * s2), a1 = *(const float4*)(fab + 32 * sj + 16 * s2 + 8);
                    float pv[8] = {cb[sj][8 * s2] * __expf(al - a0.x), cb[sj][8 * s2 + 1] * __expf(al - a0.y), cb[sj][8 * s2 + 2] * __expf(al - a0.z), cb[sj][8 * s2 + 3] * __expf(al - a0.w),
                                   cb[sj][8 * s2 + 4] * __expf(al - a1.x), cb[sj][8 * s2 + 5] * __expf(al - a1.y), cb[sj][8 * s2 + 6] * __expf(al - a1.z), cb[sj][8 * s2 + 7] * __expf(al - a1.w)};
                    if (sj == w) {
#pragma unroll
                        for (int j = 0; j < 8; ++j) pv[j] = (16 * s2 + 8 * (j >> 2) + (j & 3) <= lrel) ? pv[j] : 0.f;
                    }
                    const bf16x8 pf = __builtin_bit_cast(bf16x8, ((u32x4){pk2(pv[0], pv[1]), pk2(pv[2], pv[3]), pk2(pv[4], pv[5]), pk2(pv[6], pv[7])}));
#pragma unroll
                    for (int ni = 0; ni < 2; ++ni) {
                        const bf16_t* xa = R2 + (32 * ni + (lane & 31)) * TS + 32 * sj + 16 * s2 + fo;
                        const uint2 x0 = *(const uint2*)xa, x1 = *(const uint2*)(xa + 8);
                        const bf16x8 xf = __builtin_bit_cast(bf16x8, ((u32x4){x0.x, x0.y, x1.x, x1.y}));
                        acc[ni] = __builtin_amdgcn_mfma_f32_32x32x16_bf16(xf, pf, acc[ni], 0, 0, 0);
                    }
                }
            }
        __syncthreads();
#pragma unroll
        for (int ni = 0; ni < 2; ++ni)
#pragma unroll
            for (int q = 0; q < 4; ++q)
                *(float4*)(Y + l * 68 + 32 * ni + 8 * q + 4 * hl) = make_float4(acc[ni][4 * q], acc[ni][4 * q + 1], acc[ni][4 * q + 2], acc[ni][4 * q + 3]);
        __syncthreads();
        {
            float ssq = 0.f;
            bf16_t* yo = p.YG + (size_t)(m0 + sx) * DI + 64 * h + 32 * xh;
#pragma unroll
            for (int j = 0; j < 4; ++j) {
                const float4 ya = *(const float4*)(Y + sx * 68 + 32 * xh + 8 * j), yb = *(const float4*)(Y + sx * 68 + 32 * xh + 8 * j + 4);
                const float y0 = (ya.x + dsk * lo16(xr[j][0])) * lo16(zr[j][0]), y1 = (ya.y + dsk * hi16(xr[j][0])) * hi16(zr[j][0]);
                const float y2 = (ya.z + dsk * lo16(xr[j][1])) * lo16(zr[j][1]), y3 = (ya.w + dsk * hi16(xr[j][1])) * hi16(zr[j][1]);
                const float y4 = (yb.x + dsk * lo16(xr[j][2])) * lo16(zr[j][2]), y5 = (yb.y + dsk * hi16(xr[j][2])) * hi16(zr[j][2]);
                const float y6 = (yb.z + dsk * lo16(xr[j][3])) * lo16(zr[j][3]), y7 = (yb.w + dsk * hi16(xr[j][3])) * hi16(zr[j][3]);
                *(u32x4*)(yo + 8 * j) = (u32x4){pk2(y0, y1), pk2(y2, y3), pk2(y4, y5), pk2(y6, y7)};
                ssq += y0 * y0 + y1 * y1 + y2 * y2 + y3 * y3 + y4 * y4 + y5 * y5 + y6 * y6 + y7 * y7;
                __builtin_amdgcn_sched_barrier(0);
            }
            ssq += __shfl_xor(ssq, 1);
            if (xh == 0) p.SSQ[(size_t)(m0 + sx) * NH + h] = ssq;
            if (e8 < 7) { warm = wx[0][0] ^ wx[1][0] ^ wh[0][0] ^ wh[1][0]; if (warm == 0x9e3779b9u && p.ph_hi < 0) p.SSQ[0] = 0.f; }
        }
    }
#undef S3_PREFETCH
}
__device__ void phase_s3(const P& p, int L, bf16_t* smem) {
    for (int t = bidx(); t < NB * NCK * 4; t += vgrid()) ssdout_task(p, L, t, smem);
}

__device__ void phase_g2(const P& p, int L, bf16_t* smem, unsigned char* smem_raw) {
    big_gemm<EpiG2a>(p, L, p.OCM, p.Wt_cm + (size_t)L * DM * DM, DM, DM, smem_raw);
    big_gemm<EpiG2b>(p, L, p.YG, p.Wt_ssd + (size_t)L * DM * DI, DM, DI, smem_raw);
    for (int t = blockIdx.x; t < 8; t += gridDim.x) {
        const int m0 = MPR, n0 = t * 128;
        f32x16 acc[2][2]; ZERO_ACC(acc);
        gemm_ksplit(acc, p.OCM, DM, p.Wt_cm + (size_t)L * DM * DM, DM, DM, m0, n0, smem, smem_raw);
        if (vhalf() == 0) {
        EPI_BEGIN(acc, m0, n0)
            const uint2 gu = *(const uint2*)(p.GCM + (size_t)row * DM + col);
            st_bf4(p.MRG + (size_t)row * DM + col, v0 * lo16(gu.x), v1 * hi16(gu.x), v2 * lo16(gu.y), v3 * hi16(gu.y));
        EPI_END
        }
        ZERO_ACC(acc);
        gemm_ksplit(acc, p.YG, DI, p.Wt_ssd + (size_t)L * DM * DI, DI, DI, m0, n0, smem, smem_raw);
        if (vhalf() == 0) {
            const int lane = tidx() & 63, wave = tidx() >> 6;
#pragma unroll
            for (int mi = 0; mi < 2; ++mi) {
                const int row = m0 + (wave >> 1) * 64 + mi * 32 + (lane & 31);
                float s = 0.f;
#pragma unroll
                for (int j = 0; j < 8; ++j) { const float4 x = *(const float4*)(p.SSQ + (size_t)row * NH + 4 * j); s += x.x + x.y + x.z + x.w; }
                const float rstd = rsqrtf(s * (1.f / 2048.f) + EPS);
#pragma unroll
                for (int ni = 0; ni < 2; ++ni)
#pragma unroll
                    for (int q = 0; q < 4; ++q) {
                        const int col = n0 + (wave & 1) * 64 + ni * 32 + q * 8 + (lane >> 5) * 4;
                        const uint2 gu = *(const uint2*)(p.GSSD + (size_t)row * DM + col);
                        const uint2 pr = *(const uint2*)(p.MRG + (size_t)row * DM + col);
                        st_bf4(p.MRG + (size_t)row * DM + col, lo16(pr.x) + acc[mi][ni][4 * q] * rstd * lo16(gu.x),
                               hi16(pr.x) + acc[mi][ni][4 * q + 1] * rstd * hi16(gu.x), lo16(pr.y) + acc[mi][ni][4 * q + 2] * rstd * lo16(gu.y),
                               hi16(pr.y) + acc[mi][ni][4 * q + 3] * rstd * hi16(gu.y));
                    }
            }
        }
    }
}

__device__ void phase_g3(const P& p, int L, bf16_t* smem, unsigned char* smem_raw) {
    big_gemm<EpiG3>(p, L, p.MRG, p.Wt_o + (size_t)L * DM * DM, DM, DM, smem_raw);
    for (int t = blockIdx.x; t < 8; t += gridDim.x) {
        const int m0 = MPR, n0 = t * 128;
        f32x16 acc[2][2]; ZERO_ACC(acc);
        gemm_ksplit(acc, p.MRG, DM, p.Wt_o + (size_t)L * DM * DM, DM, DM, m0, n0, smem, smem_raw);
        if (vhalf() == 0) {
        EPI_BEGIN(acc, m0, n0)
            const float* xr = (L == 0) ? p.x_sample + (size_t)(row - MPR) * DM : p.XB + (size_t)row * DM;
            epi_res(p, L, row, col, v0, v1, v2, v3, xr, 2048);
        EPI_END
        }
    }
}

__device__ void phase_ln(const P& p, int L, int which) {
    const int lane = tidx() & 63, gw = (bidx() * THREADS + tidx()) >> 6, nw = (vgrid() * THREADS) >> 6;
    const float* gam = (which == 0 ? p.ln1_g : p.ln2_g) + L * DM;
    const float* bet = (which == 0 ? p.ln1_b : p.ln2_b) + L * DM;
    const bool last = (which == 1 && L == 1);
    constexpr int RW = 4;
    for (int m0 = RW * gw; m0 < MT; m0 += RW * nw) {
        float4 v[RW][4];
#pragma unroll
        for (int r = 0; r < RW; ++r)
#pragma unroll
            for (int j = 0; j < 4; ++j) v[r][j] = *(const float4*)(p.XB + (size_t)(m0 + r) * DM + 256 * j + 4 * lane);
        float s[RW], q[RW], mu[RW], rstd[RW];
#pragma unroll
        for (int r = 0; r < RW; ++r) { s[r] = 0.f;
#pragma unroll
            for (int j = 0; j < 4; ++j) s[r] += v[r][j].x + v[r][j].y + v[r][j].z + v[r][j].w; }
#pragma unroll
        for (int o = 32; o > 0; o >>= 1) {
#pragma unroll
            for (int r = 0; r < RW; ++r) s[r] += __shfl_xor(s[r], o); }
#pragma unroll
        for (int r = 0; r < RW; ++r) { mu[r] = s[r] * (1.f / 1024.f); q[r] = 0.f;
#pragma unroll
            for (int j = 0; j < 4; ++j) { const float a = v[r][j].x - mu[r], b = v[r][j].y - mu[r], c = v[r][j].z - mu[r], d = v[r][j].w - mu[r]; q[r] += a * a + b * b + c * c + d * d; } }
#pragma unroll
        for (int o = 32; o > 0; o >>= 1) {
#pragma unroll
            for (int r = 0; r < RW; ++r) q[r] += __shfl_xor(q[r], o); }
#pragma unroll
        for (int r = 0; r < RW; ++r) rstd[r] = rsqrtf(q[r] * (1.f / 1024.f) + EPS);
#pragma unroll
        for (int r = 0; r < RW; ++r) {
            const int m = m0 + r;
            const float* md = p.mod + (size_t)modrow(m) * MODLD + (which == 0 ? L * 6144 + 3072 : 6144);
            float* orow = last ? (m < MPR ? p.out + O0 + (size_t)m * DM : p.out + O1 + (size_t)(m - MPR) * DM) : p.XB + (size_t)m * DM;
#pragma unroll
            for (int j = 0; j < 4; ++j) {
                const int c = 256 * j + 4 * lane;
                const float4 g = *(const float4*)(gam + c), b = *(const float4*)(bet + c);
                const float4 y = make_float4((v[r][j].x - mu[r]) * rstd[r] * g.x + b.x, (v[r][j].y - mu[r]) * rstd[r] * g.y + b.y, (v[r][j].z - mu[r]) * rstd[r] * g.z + b.z, (v[r][j].w - mu[r]) * rstd[r] * g.w + b.w);
                *(float4*)(orow + c) = y;
                if (!last) {
                    const float4 sh = *(const float4*)(md + c), sc = *(const float4*)(md + 1024 + c);
                    st_bf4(p.H + (size_t)m * DM + c, y.x * (1.f + sc.x) + sh.x, y.y * (1.f + sc.y) + sh.y, y.z * (1.f + sc.z) + sh.z, y.w * (1.f + sc.w) + sh.w);
                }
            }
        }
    }
}

__device__ void phase_g4(const P& p, int L, bf16_t* smem, unsigned char* smem_raw) {
    const bf16_t* W = p.Wt_gu + (size_t)L * 2 * DFF * DM;
    big_gemm<EpiG4>(p, L, p.H, W, 2 * DFF, DM, smem_raw);
    for (int t = (bidx() + vgrid() - 256) % vgrid(); t < 44; t += vgrid()) {
        const int nt = t, m0 = MPR, n0 = nt * 128;
        f32x16 acc[2][2]; ZERO_ACC(acc);
        gemm_mainloop(acc, p.H, DM, W, DM, DM, m0, n0, smem);
        const int lane = tidx() & 63, wave = tidx() >> 6;
#pragma unroll
        for (int mi = 0; mi < 2; ++mi) {
            const int row = m0 + (wave >> 1) * 64 + mi * 32 + (lane & 31);
#pragma unroll
            for (int ni = 0; ni < 2; ++ni)
#pragma unroll
                for (int q = 0; q < 2; ++q) {
                    const int fc = 16 * (nt * 4 + (wave & 1) * 2 + ni) + q * 8 + (lane >> 5) * 4;
                    st_bf4(p.GU + (size_t)row * DFF + fc, silu_f(acc[mi][ni][4 * q]) * acc[mi][ni][8 + 4 * q], silu_f(acc[mi][ni][4 * q + 1]) * acc[mi][ni][8 + 4 * q + 1],
                           silu_f(acc[mi][ni][4 * q + 2]) * acc[mi][ni][8 + 4 * q + 2], silu_f(acc[mi][ni][4 * q + 3]) * acc[mi][ni][8 + 4 * q + 3]);
                }
        }
    }
}

__device__ void phase_g5(const P& p, int L, bf16_t* smem, unsigned char* smem_raw) {
    big_gemm<EpiG5>(p, L, p.GU, p.Wt_d + (size_t)L * DM * DFF, DM, DFF, smem_raw);
    for (int t = blockIdx.x; t < 8; t += gridDim.x) {
        const int m0 = MPR, n0 = t * 128;
        f32x16 acc[2][2]; ZERO_ACC(acc);
        gemm_ksplit(acc, p.GU, DFF, p.Wt_d + (size_t)L * DM * DFF, DFF, DFF, m0, n0, smem, smem_raw);
        if (vhalf() == 0) { EPI_BEGIN(acc, m0, n0) epi_res(p, L, row, col, v0, v1, v2, v3, p.XB + (size_t)row * DM, 5120); EPI_END }
    }
}

#define XB_TMO      128
#define XB_XCNT(j)  (256  + 64 * (j))
#define XB_XSUB(j)  (1280 + 64 * (j))
#define XB_XGEN(j)  (2304 + 64 * (j))
#define XB_TOP      3328
#define XB_TOPGEN   3392
#define XCD_BAR_WORDS 3456
#define XB_SPIN_CAP (1u << 22)
#define LAS __attribute__((address_space(3)))
__device__ __forceinline__ unsigned xb_ld(unsigned* p)              { return __hip_atomic_load(p, __ATOMIC_RELAXED, __HIP_MEMORY_SCOPE_AGENT); }
__device__ __forceinline__ unsigned xb_add(unsigned* p, unsigned v) { return __hip_atomic_fetch_add(p, v, __ATOMIC_RELAXED, __HIP_MEMORY_SCOPE_AGENT); }
__device__ __forceinline__ unsigned xb_xcc_id() { return (unsigned)__builtin_amdgcn_s_getreg((3 << 11) | 20) & 0xFu; }
#define XB_SPIN(cond, bar) do { unsigned _sp = 0; while (cond) { __builtin_amdgcn_s_sleep(1); \
    if ((++_sp & 255u) == 0u) { if (xb_ld(&(bar)[XB_TMO])) break; if (_sp > XB_SPIN_CAP) { atomicAdd(&(bar)[XB_TMO], 1u); break; } } } } while (0)
struct XcdBarrier { unsigned* bar; unsigned x; volatile LAS unsigned* st; };
__device__ __forceinline__ XcdBarrier xcd_barrier_post(unsigned* bar, volatile LAS unsigned* st) {
    XcdBarrier b; b.bar = bar; b.x = xb_xcc_id(); b.st = st;
    if (threadIdx.x == 0) (void)xb_add(&bar[XB_XCNT(b.x)], 1u);
    return b;
}
__device__ __forceinline__ void xcd_barrier_complete(unsigned* bar, unsigned x, unsigned& nloc, unsigned& nx) {
    const unsigned G = gridDim.x * gridDim.y * gridDim.z;
    unsigned sum, cnt, mine, sp = 0u;
    for (;;) {
        sum = 0u; cnt = 0u; mine = 0u;
#pragma unroll
        for (unsigned j = 0; j < 16; ++j) { const unsigned c = xb_ld(&bar[XB_XCNT(j)]); sum += c; cnt += (c > 0u) ? 1u : 0u; mine = (j == x) ? c : mine; }
        if (sum == G) break;
        __builtin_amdgcn_s_sleep(1);
        if ((++sp & 255u) == 0u) { if (xb_ld(&bar[XB_TMO])) break; if (sp > XB_SPIN_CAP) { atomicAdd(&bar[XB_TMO], 1u); break; } }
    }
    nloc = mine > 0u ? mine : 1u; nx = cnt > 0u ? cnt : 1u;
}
__device__ __forceinline__ void xcd_barrier(const XcdBarrier& b) {
    asm volatile("s_waitcnt vmcnt(0)" ::: "memory");
    __syncthreads();
    int t0 = threadIdx.x; asm volatile("" : "+v"(t0));
    if (t0 == 0) {
        unsigned* bar = b.bar;
        __builtin_amdgcn_s_waitcnt(0);
        unsigned nloc = b.st[0], nx = b.st[1];
        if (nloc == 0u) { xcd_barrier_complete(bar, b.x, nloc, nx); b.st[0] = nloc; b.st[1] = nx; }
        const unsigned old = xb_add(&bar[XB_XSUB(b.x)], 1u);
        const unsigned gen = old / nloc;
        if (old + 1u == (gen + 1u) * nloc) {
            __builtin_amdgcn_fence(__ATOMIC_RELEASE, "agent");
            asm volatile("s_waitcnt vmcnt(0)" ::: "memory");
            const unsigned og = xb_add(&bar[XB_TOP], 1u);
            const unsigned tg = og / nx;
            if (og + 1u == (tg + 1u) * nx) xb_add(&bar[XB_TOPGEN], 1u);
            else XB_SPIN(xb_ld(&bar[XB_TOPGEN]) == tg, bar);
            __builtin_amdgcn_fence(__ATOMIC_ACQUIRE, "agent");
            xb_add(&bar[XB_XGEN(b.x)], 1u);
            asm volatile("s_waitcnt vmcnt(0)" ::: "memory");
        } else {
            XB_SPIN(xb_ld(&bar[XB_XGEN(b.x)]) == gen, bar);
            __builtin_amdgcn_fence(__ATOMIC_ACQUIRE, "agent");
            asm volatile("s_waitcnt vmcnt(0)" ::: "memory");
        }
    }
    __syncthreads();
}

constexpr int N_PHASES = 3 + 2 * 11;
__global__ void __launch_bounds__(BLOCK, 2) fwd_kernel(P p) {
    extern __shared__ __attribute__((aligned(16))) unsigned char smem_raw[];
    bf16_t* smem = (bf16_t*)(smem_raw + vhalf() * HALF_LDS);
    __shared__ uint4 xb_words;
    if (threadIdx.x == 0) xb_words = make_uint4(0u, 0u, 0u, 0u);
    __syncthreads();
    const XcdBarrier xb = xcd_barrier_post(p.bar, (volatile LAS unsigned*)&xb_words);
    phase_w(p, (float*)smem);
    if (p.ph_hi < 0) cg::this_grid().sync();
    xcd_barrier(xb);
    for (int ph = 1; ph < p.ph_hi; ++ph) {
        if (ph == 1) phase_ada(p, smem);
        else if (ph == 2) phase_e0(p);
        else {
            const int L = (ph - 3) / 11, s = (ph - 3) % 11;
            switch (s) {
                case 0: phase_g1(p, L, smem, smem_raw); break;
                case 1: phase_c(p, L); break;
                case 2: phase_s1(p, L, smem); break;
                case 3: phase_s2(p, L); break;
                case 4: phase_s3(p, L, smem); break;
                case 5: phase_g2(p, L, smem, smem_raw); break;
                case 6: phase_g3(p, L, smem, smem_raw); break;
                case 7: phase_ln(p, L, 0); break;
                case 8: phase_g4(p, L, smem, smem_raw); break;
                case 9: phase_g5(p, L, smem, smem_raw); break;
                default: phase_ln(p, L, 1); break;
            }
        }
        if (ph + 1 < p.ph_hi) xcd_barrier(xb);
    }
}

extern "C" void kernel_launch(void* const* d_in, const int* in_sizes, int n_in, void* d_out, int out_size, void* d_ws, size_t ws_size, hipStream_t stream) {
    static int grid = 0;
    if (grid == 0) {
        int dev = 0, cus = 0, per_cu = 0;
        (void)hipGetDevice(&dev);
        (void)hipDeviceGetAttribute(&cus, hipDeviceAttributeMultiprocessorCount, dev);
        (void)hipFuncSetAttribute((const void*)fwd_kernel, hipFuncAttributeMaxDynamicSharedMemorySize, LDS_BYTES);
        (void)hipOccupancyMaxActiveBlocksPerMultiprocessor(&per_cu, (const void*)fwd_kernel, BLOCK, LDS_BYTES);
        if (per_cu != 1) per_cu = 1;
        grid = cus * per_cu;
        fprintf(stderr, "kernel_launch: cus %d per_cu %d grid %d\n", cus, per_cu, grid);
    }
    P p{};
    const float** ip = (const float**)&p;
    for (int i = 0; i < 30; ++i) ip[i] = (const float*)d_in[i];
    p.out = (float*)d_out;
    unsigned char* w = (unsigned char*)d_ws;
    size_t off = 0;
    auto take = [&](size_t bytes) { unsigned char* r = w + off; off += (bytes + 255) & ~(size_t)255; return r; };
    p.Wt_in = (bf16_t*)take((size_t)2 * NIN * DM * 2);
    p.Wt_cm = (bf16_t*)take((size_t)2 * DM * DM * 2);
    p.Wt_ssd = (bf16_t*)take((size_t)2 * DM * DI * 2);
    p.Wt_o = (bf16_t*)take((size_t)2 * DM * DM * 2);
    p.Wt_gu = (bf16_t*)take((size_t)2 * 2 * DFF * DM * 2);
    p.Wt_d = (bf16_t*)take((size_t)2 * DM * DFF * 2);
    p.Wt_ada = (bf16_t*)take((size_t)2 * 6144 * DM * 2);
    p.SC = (bf16_t*)take((size_t)256 * DM * 2);
    p.mod = (float*)take((size_t)NMOD * MODLD * 4);
    p.XB = (float*)take((size_t)MT * DM * 4);
    p.H = (bf16_t*)take((size_t)MT * DM * 2);
    p.DT = (float*)take((size_t)MT * NH * 4);
    p.VST = (float*)take((size_t)MT * 2 * 4);
    p.ST = (float*)take((size_t)NB * NCK * NH * 64 * 128 * 4);
    p.CDEC = (float*)take((size_t)NB * NCK * NH * 4);
    p.ST16 = (bf16_t*)take((size_t)NB * NCK * NH * 64 * 128 * 2);
    p.SSQ = (float*)take((size_t)MT * NH * 4);
    p.UG = (bf16_t*)take((size_t)MT * DM * 2);
    p.VG = (bf16_t*)take((size_t)MT * DM * 2);
    p.SZ = (bf16_t*)take((size_t)MT * DI * 2);
    p.GU = p.UG;
    p.XBC = (bf16_t*)take((size_t)MT * CD * 2);
    p.GCM = (bf16_t*)take((size_t)MT * DM * 2);
    p.GSSD = (bf16_t*)take((size_t)MT * DM * 2);
    p.XC = (bf16_t*)take((size_t)MT * CD * 2);
    p.OCM = (bf16_t*)take((size_t)MT * DM * 2);
    p.YG = (bf16_t*)take((size_t)MT * DI * 2);
    p.MRG = (bf16_t*)take((size_t)MT * DM * 2);
    p.bar = (unsigned*)take((size_t)XCD_BAR_WORDS * 4);
    if (off > ws_size) { fprintf(stderr, "kernel_launch: workspace too small: need %zu have %zu\n", off, ws_size); return; }
    p.ph_lo = 0; p.ph_hi = N_PHASES; p.coop = 1;
    (void)hipMemsetAsync(p.bar, 0, (size_t)XCD_BAR_WORDS * 4, stream);
    void* args[] = {&p};
    hipError_t e = hipLaunchCooperativeKernel((const void*)fwd_kernel, dim3(grid), dim3(BLOCK), args, LDS_BYTES, stream);
    if (e != hipSuccess) fprintf(stderr, "cooperative launch failed: %s (grid %d)\n", hipGetErrorString(e), grid);
}
```
